# Optimizing an MI355X kernel written in HIP

```python
import jax, jax.numpy as jnp
from jax import lax
import numpy as np

D_MODEL = 1024
BATCH = 8
SEQ = 4096
DEPTH = 2

EPS = 1e-6
CONV_WIDTH = 3
A_HEADS = 8
A_HEAD_DIM = 64
A_WIDTH = A_HEADS * A_HEAD_DIM
POOL_WINDOWS = (2, 4, 8, 16)
B_GROUPS = len(POOL_WINDOWS)
B_GROUP_DIM = 128
B_WIDTH = B_GROUPS * B_GROUP_DIM
EVEN_IN = 3 * A_WIDTH + B_WIDTH
EVEN_MIX = A_WIDTH + B_WIDTH
CHUNK = 128
C_HEADS = 8
C_HEAD_DIM = 128
C_WIDTH = C_HEADS * C_HEAD_DIM
D_FF = 2816

N_EVEN = (DEPTH + 1) // 2
N_ODD = DEPTH // 2

kernel_name = "hybrid_conv_pool_sgu_trunk"


def rms_norm(x, g):
    x32 = x.astype(jnp.float32)
    y = x32 * lax.rsqrt(jnp.mean(x32 * x32, axis=-1, keepdims=True) + EPS)
    return y.astype(x.dtype) * g


def causal_dwconv3(x, w):
    s = x.shape[1]
    xp = jnp.pad(x, ((0, 0), (CONV_WIDTH - 1, 0), (0, 0)))
    y = xp[:, 0:s] * w[0]
    for k in range(1, CONV_WIDTH):
        y = y + xp[:, k:k + s] * w[k]
    return y


def short_gated_conv(gate_b, gate_c, val, conv_w):
    return gate_b * causal_dwconv3(gate_c * val, conv_w)


def multiscale_pool(z, w_pool, pool_scale):
    b, s, _ = z.shape
    z32 = z.astype(jnp.float32).reshape(b, s, B_GROUPS, B_GROUP_DIM)
    cs = jnp.cumsum(z32, axis=1)
    pos = jnp.arange(1, s + 1, dtype=jnp.float32)[None, :, None]
    outs = []
    for g, w in enumerate(POOL_WINDOWS):
        csg = cs[:, :, g]
        shifted = jnp.pad(csg, ((0, 0), (w, 0), (0, 0)))[:, :s]
        count = jnp.minimum(pos, jnp.float32(w))
        outs.append((csg - shifted) / count - z32[:, :, g])
    pooled = jnp.stack(outs, axis=2).astype(z.dtype)
    mixed = jnp.einsum('bsgc,gcd->bsgd', pooled, w_pool)
    return mixed.reshape(b, s, B_WIDTH) * pool_scale


def chunked_spatial_gating(u, v, sgu_norm, w_spatial, b_spatial):
    b, s, _ = u.shape
    n = s // CHUNK
    vn = rms_norm(v, sgu_norm).reshape(b, n, CHUNK, C_HEADS, C_HEAD_DIM)
    mask = jnp.tril(jnp.ones((CHUNK, CHUNK), dtype=w_spatial.dtype))
    ws = w_spatial * mask
    gate = jnp.einsum('hts,bnshc->bnthc', ws, vn) + b_spatial.T[None, None, :, :, None]
    return u * gate.reshape(b, s, C_WIDTH)


def gated_conv_ffn(x, w_gate, w_up, conv_w, conv_b, w_down):
    g = jnp.einsum('bsd,df->bsf', x, w_gate)
    g = causal_dwconv3(g, conv_w) + conv_b
    up = jnp.einsum('bsd,df->bsf', x, w_up)
    return jnp.einsum('bsf,fd->bsd', jax.nn.silu(g) * up, w_down)


def setup_inputs(seed: int = 0) -> dict:
    key = jax.random.key(seed)
    ks = jax.random.split(key, 20)
    f32 = jnp.float32
    nrm = lambda k, shape, s: jax.random.normal(k, shape, f32) * s
    return {
        "x": nrm(ks[0], (BATCH, SEQ, D_MODEL), 1.0),
        "norm_mix": 1.0 + nrm(ks[1], (DEPTH, D_MODEL), 0.05),
        "norm_ffn": 1.0 + nrm(ks[2], (DEPTH, D_MODEL), 0.05),
        "final_norm": 1.0 + nrm(ks[3], (D_MODEL,), 0.05),
        "w_in_even": nrm(ks[4], (N_EVEN, D_MODEL, EVEN_IN), D_MODEL ** -0.5),
        "conv_a": nrm(ks[5], (N_EVEN, CONV_WIDTH, A_WIDTH), CONV_WIDTH ** -0.5),
        "w_pool": nrm(ks[6], (N_EVEN, B_GROUPS, B_GROUP_DIM, B_GROUP_DIM), B_GROUP_DIM ** -0.5),
        "pool_scale": 1.0 + nrm(ks[7], (N_EVEN, B_WIDTH), 0.1),
        "w_out_even": nrm(ks[8], (N_EVEN, EVEN_MIX, D_MODEL), EVEN_MIX ** -0.5),
        "w_in_odd": nrm(ks[9], (N_ODD, D_MODEL, 2 * C_WIDTH), D_MODEL ** -0.5),
        "sgu_norm": 1.0 + nrm(ks[10], (N_ODD, C_WIDTH), 0.05),
        "w_spatial": nrm(ks[11], (N_ODD, C_HEADS, CHUNK, CHUNK), CHUNK ** -0.5),
        "b_spatial": 1.0 + nrm(ks[12], (N_ODD, C_HEADS, CHUNK), 0.05),
        "w_out_odd": nrm(ks[13], (N_ODD, C_WIDTH, D_MODEL), C_WIDTH ** -0.5),
        "w_ffn_gate": nrm(ks[14], (DEPTH, D_MODEL, D_FF), D_MODEL ** -0.5),
        "w_ffn_up": nrm(ks[15], (DEPTH, D_MODEL, D_FF), D_MODEL ** -0.5),
        "conv_ffn": nrm(ks[16], (DEPTH, CONV_WIDTH, D_FF), CONV_WIDTH ** -0.5),
        "b_conv_ffn": nrm(ks[17], (DEPTH, D_FF), 0.02),
        "w_ffn_down": nrm(ks[18], (DEPTH, D_FF, D_MODEL), D_FF ** -0.5),
    }


def reference(x, norm_mix, norm_ffn, final_norm, w_in_even, conv_a, w_pool, pool_scale,
              w_out_even, w_in_odd, sgu_norm, w_spatial, b_spatial, w_out_odd,
              w_ffn_gate, w_ffn_up, conv_ffn, b_conv_ffn, w_ffn_down):
    h = x
    for layer in range(DEPTH):
        xn = rms_norm(h, norm_mix[layer])
        if layer % 2 == 0:
            i = layer // 2
            proj = jnp.einsum('bsd,de->bse', xn, w_in_even[i])
            a_b = proj[..., 0:A_WIDTH]
            a_c = proj[..., A_WIDTH:2 * A_WIDTH]
            a_v = proj[..., 2 * A_WIDTH:3 * A_WIDTH]
            z_b = proj[..., 3 * A_WIDTH:]
            y_a = short_gated_conv(a_b, a_c, a_v, conv_a[i])
            y_b = multiscale_pool(z_b, w_pool[i], pool_scale[i])
            mix = jnp.concatenate([y_a, y_b], axis=-1)
            h = h + jnp.einsum('bse,ed->bsd', mix, w_out_even[i])
        else:
            i = layer // 2
            proj = jax.nn.gelu(jnp.einsum('bsd,de->bse', xn, w_in_odd[i]), approximate=False)
            u = proj[..., :C_WIDTH]
            v = proj[..., C_WIDTH:]
            mix = chunked_spatial_gating(u, v, sgu_norm[i], w_spatial[i], b_spatial[i])
            h = h + jnp.einsum('bse,ed->bsd', mix, w_out_odd[i])
        hn = rms_norm(h, norm_ffn[layer])
        h = h + gated_conv_ffn(hn, w_ffn_gate[layer], w_ffn_up[layer], conv_ffn[layer],
                               b_conv_ffn[layer], w_ffn_down[layer])
    return rms_norm(h, final_norm)
```

```cpp
#include <hip/hip_runtime.h>
#include <cstdio>
#include <cstdint>
namespace pg8 {
#define PG8_LAS __attribute__((address_space(3)))
typedef unsigned short bf16_t;
typedef short bf16x8 __attribute__((ext_vector_type(8)));
typedef float f32x4 __attribute__((ext_vector_type(4)));
typedef unsigned u32x4 __attribute__((ext_vector_type(4)));
constexpr int BM = 256, BK = 64, HALF = 128, HTB = HALF * BK * 2  , STAGE_BYTES = 8 * HTB, NXCD = 8, WGM = 8;

__host__ __device__ __forceinline__ int lds_byte(int r, int c) { const int st = (r >> 4) * 2 + (c >> 5), rr = r & 15, cc = c & 31, ob = rr * 64 + cc * 2; return st * 1024 + (ob ^ (((ob >> 9) & 1) << 5)); }
__host__ __device__ __forceinline__ void stage_rc(int b, int& R, int& C) { const int st = b / 1024, sb = b % 1024, swz = sb ^ (((sb >> 9) & 1) << 5); R = (st >> 1) * 16 + swz / 64; C = (st & 1) * 32 + (swz % 64) / 2; }
__host__ __device__ __forceinline__ int perm32(int rho) { const int n = rho >> 4, i = rho & 15; return 8 * (i >> 2) + 4 * n + (i & 3); }

struct Unit { int pm, pn; };
struct Gemm { const bf16_t* A; const bf16_t* Bt; int M, N, K; };

struct StaticOrder {
    int nM, nN, nwg, G, c;
    __host__ __device__ void init(int M, int N, int G_, int c_) { nM = M / BM; nN = N / BM; nwg = nM * nN; G = G_; c = c_; }
    __host__ __device__ bool next(int i, Unit& u) const {
        const long L = (long)i * G + c; if (L >= nwg) return false;
        int wgid = (int)L; { const int q = nwg / NXCD, r = nwg % NXCD, xcd = wgid % NXCD, off = wgid / NXCD; wgid = (xcd < r ? xcd * (q + 1) : r * (q + 1) + (xcd - r) * q) + off; }
        const int nig = WGM * nN, gid = wgid / nig, fm = gid * WGM, gsz = (nM - fm) < WGM ? (nM - fm) : WGM;
        u.pm = fm + ((wgid % nig) % gsz); u.pn = (wgid % nig) / gsz; return true;
    }
    __device__ __forceinline__ void a_ready(const Unit&) const {}
    __device__ __forceinline__ void done(const Unit&) const {}
};

__device__ __forceinline__ unsigned cvt_pk_bf16(float lo, float hi) { unsigned r; asm volatile("v_cvt_pk_bf16_f32 %0, %1, %2" : "=v"(r) : "v"(lo), "v"(hi)); return r; }
typedef float f32x2 __attribute__((ext_vector_type(2)));
__device__ __forceinline__ f32x2 gelu_pk(f32x2 v) {
    const f32x2 av = __builtin_elementwise_abs(v), d = av * 0.2316418882f + 1.0f;
    f32x2 t; t.x = __builtin_amdgcn_rcpf(d.x); t.y = __builtin_amdgcn_rcpf(d.y);
    f32x2 q = t * 0.5307027145f + (-0.7265760135f); q = q * t + 0.7107068705f; q = q * t + (-0.142248368f); q = q * t + 0.127414796f; q = q * t;
    const f32x2 s = (v * v) * (-0.72134752044f);
    f32x2 e; e.x = __builtin_amdgcn_exp2f(s.x); e.y = __builtin_amdgcn_exp2f(s.y);
    const f32x2 m = v * (q * e), r = v - m;
    f32x2 o; o.x = v.x < 0.f ? m.x : r.x; o.y = v.y < 0.f ? m.y : r.y; return o;
}

constexpr float RMS_EPS = 1e-6f;
__device__ __forceinline__ float rinv_from_part(const float* part, int row) {
    const f32x4* pp = (const f32x4*)(part + (size_t)row * 16); const f32x4 p0 = pp[0], p1 = pp[1], p2 = pp[2], p3 = pp[3];
    const float s = (((p0[0] + p0[1]) + (p0[2] + p0[3])) + ((p1[0] + p1[1]) + (p1[2] + p1[3]))) + (((p2[0] + p2[1]) + (p2[2] + p2[3])) + ((p3[0] + p3[1]) + (p3[2] + p3[3])));
    return 1.0f / sqrtf(s * (1.0f / 1024.0f) + RMS_EPS);
}
__device__ __forceinline__ float gelu_erf(float v) { return 0.5f * v * (1.0f + erff(v * 0.70710678118654752f)); }

template <int ACT, bool VSS> struct EpiProj {
    static constexpr bool PERM = true, AFTER_DRAIN = false;
    bf16_t* O; int ldc; int split_cols; size_t split_stride; const float* pin; float* pout; int pn0;
    __device__ __forceinline__ void operator()(const f32x4 (&acc)[2][2][4][2], const Unit& u, int wr, int wc, int fr, int fq) const {
        const int row0 = u.pm * BM + wr * 64 + fr; int colt = u.pn * BM; bf16_t* base = O;
        if (split_cols) { const int t = colt / split_cols; base += (size_t)t * split_stride; colt -= t * split_cols; }
        const int col0 = colt + wc * 32 + 8 * fq;
#pragma unroll
        for (int ai = 0; ai < 2; ++ai)
#pragma unroll
            for (int m = 0; m < 4; ++m) { const int row = row0 + ai * HALF + m * 16; const float ri = rinv_from_part(pin, row);
                bf16_t* rowp = base + (size_t)row * ldc + col0; float ss = 0.f;
#pragma unroll
                for (int bj = 0; bj < 2; ++bj) { f32x4 v0 = acc[ai][bj][m][0] * ri, v1 = acc[ai][bj][m][1] * ri;
                    if (ACT == 1) {
#pragma unroll
                        for (int j = 0; j < 4; ++j) { v0[j] = gelu_erf(v0[j]); v1[j] = gelu_erf(v1[j]); } }
                    if (VSS) ss += ((v0[0] * v0[0] + v0[1] * v0[1]) + (v0[2] * v0[2] + v0[3] * v0[3])) + ((v1[0] * v1[0] + v1[1] * v1[1]) + (v1[2] * v1[2] + v1[3] * v1[3]));
                    u32x4 w; w.x = cvt_pk_bf16(v0[0], v0[1]); w.y = cvt_pk_bf16(v0[2], v0[3]); w.z = cvt_pk_bf16(v1[0], v1[1]); w.w = cvt_pk_bf16(v1[2], v1[3]);
                    *(u32x4*)(rowp + bj * HALF) = w; }
                if (VSS) { ss += __shfl_xor(ss, 16); ss += __shfl_xor(ss, 32); if (fq == 0 && u.pn >= pn0) pout[(size_t)row * 16 + (u.pn - pn0) * 4 + wc] = ss; }
                asm volatile("" ::: "memory"); }
    }
};

template <bool HB> struct EpiResid {
    static constexpr bool PERM = true, AFTER_DRAIN = false;
    const float* base; float* out; bf16_t* hb; float* pout;
    __device__ __forceinline__ void operator()(const f32x4 (&acc)[2][2][4][2], const Unit& u, int wr, int wc, int fr, int fq) const {
        const int row0 = u.pm * BM + wr * 64 + fr, col0 = u.pn * BM + wc * 32 + 8 * fq;
#pragma unroll
        for (int ai = 0; ai < 2; ++ai)
#pragma unroll
            for (int m = 0; m < 4; ++m) { const int row = row0 + ai * HALF + m * 16; const size_t off = (size_t)row * 1024 + col0; float ss = 0.f;
#pragma unroll
                for (int bj = 0; bj < 2; ++bj) { const f32x4 b0 = *(const f32x4*)(base + off + bj * HALF), b1 = *(const f32x4*)(base + off + bj * HALF + 4);
                    const f32x4 h0 = b0 + acc[ai][bj][m][0], h1 = b1 + acc[ai][bj][m][1];
                    *(f32x4*)(out + off + bj * HALF) = h0; *(f32x4*)(out + off + bj * HALF + 4) = h1;
                    if (HB) { ss += ((h0[0] * h0[0] + h0[1] * h0[1]) + (h0[2] * h0[2] + h0[3] * h0[3])) + ((h1[0] * h1[0] + h1[1] * h1[1]) + (h1[2] * h1[2] + h1[3] * h1[3]));
                        u32x4 w; w.x = cvt_pk_bf16(h0[0], h0[1]); w.y = cvt_pk_bf16(h0[2], h0[3]); w.z = cvt_pk_bf16(h1[0], h1[1]); w.w = cvt_pk_bf16(h1[2], h1[3]);
                        *(u32x4*)(hb + off + bj * HALF) = w; } }
                if (HB) { ss += __shfl_xor(ss, 16); ss += __shfl_xor(ss, 32); if (fq == 0) pout[(size_t)row * 16 + u.pn * 4 + wc] = ss; }
                asm volatile("" ::: "memory"); }
    }
};
template <class Epi, class Sched, bool ALIGN_EPI = false, bool SP2 = false>
__device__ __forceinline__ void gemm_phase(PG8_LAS unsigned char* lds, const Gemm g, const Sched& S, const Epi& E) {
    const int tid = threadIdx.x, wid = __builtin_amdgcn_readfirstlane(tid >> 6), lane = tid & 63, wr = wid >> 2, wc = wid & 3, fr = lane & 15, fq = lane >> 4;
    const int K = g.K, nt = K / BK;
    unsigned voffA[2], voffB[2];
#pragma unroll
    for (int i = 0; i < 2; ++i) { int R, C; stage_rc(tid * 16 + i * 8192, R, C); const int Rb = Epi::PERM ? ((R & ~31) + perm32(R & 31)) : R;
        voffA[i] = (unsigned)(R * K + C) * 2u; voffB[i] = (unsigned)(Rb * K + C) * 2u; }
    const size_t kstep = (size_t)(BK * 2);
    const size_t hstep = (size_t)HALF * K * 2;
    const size_t tstep = 2 * hstep;
    const unsigned ldsw = (unsigned)wid * 1024u;
    const int aoff = lds_byte(wr * 64 + fr, fq * 8), boff = lds_byte(wc * 32 + fr, fq * 8);
#define PG8_SA(b, h) (((b) * 2 + (h)) * HTB)
#define PG8_SB(b, h) ((4 + (b) * 2 + (h)) * HTB)
#define PG8_STAGE(bufoff, gbase, voff) do { _Pragma("unroll") for (int _i = 0; _i < 2; ++_i) \
        __builtin_amdgcn_global_load_lds((const unsigned*)((const char*)(gbase) + (voff)[_i]), (PG8_LAS unsigned*)(lds + (bufoff) + ldsw + _i * 8192), 16, 0, 0); } while (0)
#define PG8_LDA(dst, b, h) do { _Pragma("unroll") for (int m = 0; m < 4; ++m) _Pragma("unroll") for (int k = 0; k < 2; ++k) dst[m][k] = *(const PG8_LAS bf16x8*)(lds + PG8_SA(b, h) + aoff + m * 2048 + k * 1024); } while (0)
#define PG8_LDB(dst, b, h) do { _Pragma("unroll") for (int n = 0; n < 2; ++n) _Pragma("unroll") for (int k = 0; k < 2; ++k) dst[n][k] = *(const PG8_LAS bf16x8*)(lds + PG8_SB(b, h) + boff + n * 2048 + k * 1024); } while (0)
#define PG8_MMA(ai, bj, At, Bt) do { __builtin_amdgcn_s_setprio(1); _Pragma("unroll") for (int m = 0; m < 4; ++m) _Pragma("unroll") for (int n = 0; n < 2; ++n) _Pragma("unroll") for (int k = 0; k < 2; ++k) \
        acc[ai][bj][m][n] = __builtin_amdgcn_mfma_f32_16x16x32_bf16(Bt[n][k], At[m][k], acc[ai][bj][m][n], 0, 0, 0); __builtin_amdgcn_s_setprio(0); } while (0)
#define PG8_WAIT_V(n) asm volatile("s_waitcnt vmcnt(" #n ")" ::: "memory")
#define PG8_WAIT_L(n) asm volatile("s_waitcnt lgkmcnt(" #n ")" ::: "memory")
#define PG8_BAR __builtin_amdgcn_s_barrier()
#define PG8_SCHED __builtin_amdgcn_sched_barrier(0)
    Unit cur, nxt; int ui = 0;
    if (!S.next(0, cur)) return;
    f32x4 acc[2][2][4][2];
#pragma unroll
    for (int a = 0; a < 2; ++a)
#pragma unroll
        for (int b = 0; b < 2; ++b)
#pragma unroll
            for (int m = 0; m < 4; ++m)
#pragma unroll
                for (int n = 0; n < 2; ++n) acc[a][b][m][n] = (f32x4){0.f, 0.f, 0.f, 0.f};
    bf16x8 At[4][2], B0[2][2], B1[2][2];
    const char* cA = (const char*)g.A + (size_t)cur.pm * tstep; const char* cB = (const char*)g.Bt + (size_t)cur.pn * tstep;
    S.a_ready(cur);
    if constexpr (SP2) {
        PG8_STAGE(PG8_SB(0, 0), cB, voffB); PG8_STAGE(PG8_SB(0, 1), cB + hstep, voffB); PG8_STAGE(PG8_SA(0, 0), cA, voffA); PG8_STAGE(PG8_SA(0, 1), cA + hstep, voffA);
        if (wr == 1) PG8_BAR;
        PG8_WAIT_V(2); PG8_BAR;
        PG8_STAGE(PG8_SB(1, 0), cB + kstep, voffB); PG8_STAGE(PG8_SA(1, 0), cA + kstep, voffA); PG8_STAGE(PG8_SB(1, 1), cB + hstep + kstep, voffB);
        PG8_WAIT_V(6); PG8_BAR;
    } else {
        PG8_STAGE(PG8_SB(0, 0), cB, voffB); PG8_STAGE(PG8_SA(0, 0), cA, voffA); PG8_STAGE(PG8_SB(0, 1), cB + hstep, voffB); PG8_STAGE(PG8_SA(0, 1), cA + hstep, voffA);
        if (wr == 1) PG8_BAR;
        PG8_WAIT_V(4); PG8_BAR;
        PG8_STAGE(PG8_SB(1, 0), cB + kstep, voffB); PG8_STAGE(PG8_SA(1, 0), cA + kstep, voffA); PG8_STAGE(PG8_SB(1, 1), cB + hstep + kstep, voffB);
        PG8_WAIT_V(6); PG8_BAR;
    }
    for (;;) {
        const bool has_next = S.next(ui + 1, nxt);
        const char* nA = has_next ? (const char*)g.A + (size_t)nxt.pm * tstep : cA; const char* nB = has_next ? (const char*)g.Bt + (size_t)nxt.pn * tstep : cB;
        for (int t = 0; t < nt; t += 2) {
            const bool last = (t == nt - 2);
            const char* a1 = cA + (size_t)(t + 1) * kstep;
            const char* a2 = last ? nA : cA + (size_t)(t + 2) * kstep; const char* b2 = last ? nB : cB + (size_t)(t + 2) * kstep;
            const char* a3 = a2 + kstep; const char* b3 = b2 + kstep;
            if (last && has_next) S.a_ready(nxt);
            if constexpr (SP2) {
            PG8_LDB(B0, 0, 0); PG8_LDB(B1, 0, 1); PG8_SCHED; PG8_LDA(At, 0, 0); PG8_STAGE(PG8_SA(1, 1), a1 + hstep, voffA);
            PG8_WAIT_V(8); PG8_WAIT_L(0); PG8_BAR; PG8_MMA(0, 0, At, B0); PG8_MMA(0, 1, At, B1); PG8_BAR; PG8_SCHED;
            PG8_LDA(At, 0, 1); PG8_STAGE(PG8_SB(0, 0), b2, voffB); PG8_STAGE(PG8_SB(0, 1), b2 + hstep, voffB); PG8_STAGE(PG8_SA(0, 0), a2, voffA);
            PG8_WAIT_V(8); PG8_WAIT_L(0); PG8_BAR; PG8_MMA(1, 0, At, B0); PG8_MMA(1, 1, At, B1); PG8_BAR; PG8_SCHED;
            PG8_LDB(B0, 1, 0); PG8_LDB(B1, 1, 1); PG8_SCHED; PG8_LDA(At, 1, 0); PG8_STAGE(PG8_SA(0, 1), a2 + hstep, voffA);
            PG8_WAIT_V(8); PG8_WAIT_L(0); PG8_BAR; PG8_MMA(0, 0, At, B0); PG8_MMA(0, 1, At, B1); PG8_BAR; PG8_SCHED;
            PG8_LDA(At, 1, 1); PG8_STAGE(PG8_SB(1, 0), b3, voffB); PG8_STAGE(PG8_SB(1, 1), b3 + hstep, voffB); PG8_STAGE(PG8_SA(1, 0), a3, voffA);
            PG8_WAIT_V(8); PG8_WAIT_L(0); PG8_BAR; PG8_MMA(1, 0, At, B0); PG8_MMA(1, 1, At, B1); PG8_BAR; PG8_SCHED;
            } else {
            PG8_LDB(B0, 0, 0); PG8_SCHED; PG8_LDA(At, 0, 0); PG8_STAGE(PG8_SA(1, 1), a1 + hstep, voffA);
            PG8_WAIT_L(8); PG8_BAR; PG8_WAIT_L(0); PG8_MMA(0, 0, At, B0); PG8_BAR; PG8_SCHED;
            PG8_LDB(B1, 0, 1); PG8_STAGE(PG8_SB(0, 0), b2, voffB);
            PG8_BAR; PG8_WAIT_L(0); PG8_MMA(0, 1, At, B1); PG8_BAR;
            PG8_LDA(At, 0, 1); PG8_STAGE(PG8_SA(0, 0), a2, voffA);
            PG8_BAR; PG8_WAIT_L(0); PG8_MMA(1, 0, At, B0); PG8_BAR; PG8_SCHED;
            PG8_STAGE(PG8_SB(0, 1), b2 + hstep, voffB);
            PG8_WAIT_V(6); PG8_BAR; PG8_MMA(1, 1, At, B1); PG8_BAR;
            PG8_LDB(B0, 1, 0); PG8_SCHED; PG8_LDA(At, 1, 0); PG8_STAGE(PG8_SA(0, 1), a2 + hstep, voffA);
            PG8_WAIT_L(8); PG8_BAR; PG8_WAIT_L(0); PG8_MMA(0, 0, At, B0); PG8_BAR; PG8_SCHED;
            PG8_LDB(B1, 1, 1); PG8_STAGE(PG8_SB(1, 0), b3, voffB);
            PG8_BAR; PG8_WAIT_L(0); PG8_MMA(0, 1, At, B1); PG8_BAR;
            PG8_LDA(At, 1, 1); PG8_STAGE(PG8_SA(1, 0), a3, voffA);
            PG8_BAR; PG8_WAIT_L(0); PG8_MMA(1, 0, At, B0); PG8_BAR; PG8_SCHED;
            PG8_STAGE(PG8_SB(1, 1), b3 + hstep, voffB);
            PG8_WAIT_V(6); PG8_BAR; PG8_MMA(1, 1, At, B1); PG8_BAR;
            }
        }
        if constexpr (ALIGN_EPI) { if (wr == 0) PG8_BAR; }
        if constexpr (!Epi::AFTER_DRAIN) { E(acc, cur, wr, wc, fr, fq); S.done(cur); }
        if (!has_next) break;
#pragma unroll
        for (int a = 0; a < 2; ++a)
#pragma unroll
            for (int b = 0; b < 2; ++b)
#pragma unroll
                for (int m = 0; m < 4; ++m)
#pragma unroll
                    for (int n = 0; n < 2; ++n) acc[a][b][m][n] = (f32x4){0.f, 0.f, 0.f, 0.f};
        cur = nxt; cA = nA; cB = nB; ++ui;
        if constexpr (ALIGN_EPI) { if (wr == 1) PG8_BAR; }
    }
    PG8_WAIT_V(0);
    if constexpr (!ALIGN_EPI) { if (wr == 0) PG8_BAR; }
    PG8_BAR;
    if constexpr (Epi::AFTER_DRAIN) { E.fused(acc, cur, wr, wc, fr, fq, lds, wid, lane); S.done(cur); }
#undef PG8_SA
#undef PG8_SB
#undef PG8_STAGE
#undef PG8_LDA
#undef PG8_LDB
#undef PG8_MMA
#undef PG8_WAIT_V
#undef PG8_WAIT_L
#undef PG8_BAR
#undef PG8_SCHED
}
}

constexpr int NWAVES = 8;
#ifndef MK_PER_PHASE
#define MK_PER_PHASE 0
#endif
constexpr int NPHASE = 14;

constexpr int BATCH = 8, SEQ = 4096, D = 1024, M = BATCH * SEQ;
constexpr int AW = 512, EVEN_IN = 2048, DFF = 2816, NGU = 2 * DFF;
constexpr int RUN = 32;

constexpr size_t MiB = 1u << 20;
constexpr size_t WS_CTL = 0, CTL_ZERO_BYTES = 64 * 1024;
constexpr size_t WS_WIN0 = 1 * MiB, WS_WOUT0 = 5 * MiB, WS_WIN1 = 7 * MiB, WS_WOUT1 = 11 * MiB, WS_WGU0 = 13 * MiB, WS_WGU1 = 24 * MiB;
constexpr size_t WS_WD0 = 35 * MiB, WS_WD1 = WS_WD0 + (size_t)D * DFF * 2, WS_PART = 46 * MiB;
constexpr size_t PART_BYTES = (size_t)M * 16 * 4;
constexpr size_t WS_HB = 64 * MiB;
constexpr size_t WS_C = 128 * MiB;
constexpr size_t WS_PROJ = WS_C, WS_MIX = WS_C + 128 * MiB;
constexpr size_t WS_G = WS_C, WS_UP = WS_C + 176 * MiB, WS_H4 = WS_C;
constexpr size_t WS_END = WS_C + 352 * MiB;
static_assert(WS_WD1 + (size_t)D * DFF * 2 <= WS_PART && WS_PART + 5 * PART_BYTES <= WS_HB && WS_HB + (size_t)M * D * 2 <= WS_C, "ws map");
static_assert((size_t)M * DFF * 2 == 176 * MiB && (size_t)M * EVEN_IN * 2 == 128 * MiB, "ws map sizes");
constexpr int CW_BAR = 4096;

constexpr int RING_OFF = 0, RING_BYTES = 131072;
constexpr int LDSCTL_OFF = RING_BYTES, MISC_OFF = LDSCTL_OFF + 320;
constexpr int LDS_BYTES = 147456;
static_assert(MISC_OFF + 128 <= LDS_BYTES, "LDS map");

#define GAS __attribute__((address_space(1)))
#define LAS __attribute__((address_space(3)))
typedef unsigned short bf16;
typedef unsigned v4u __attribute__((ext_vector_type(4)));
typedef float f32x4 __attribute__((ext_vector_type(4)));
typedef short bf16x8 __attribute__((ext_vector_type(8)));
typedef GAS unsigned gu32;
typedef GAS unsigned long long gu64;
#define RLX_AGENT __ATOMIC_RELAXED, __HIP_MEMORY_SCOPE_AGENT
#define LDS_WAIT() asm volatile("s_waitcnt lgkmcnt(0)" ::: "memory")
#define VM_WAIT() asm volatile("s_waitcnt vmcnt(0)" ::: "memory")
__device__ __forceinline__ unsigned long long rt() { return __builtin_amdgcn_s_memrealtime(); }
__device__ __forceinline__ unsigned f2bf(float f) { unsigned u = __builtin_bit_cast(unsigned, f); return (u + 0x7fffu + ((u >> 16) & 1u)) >> 16; }
__device__ __forceinline__ unsigned pk2(float lo, float hi) { return f2bf(lo) | (f2bf(hi) << 16); }

#define XB_TMO      128
#define XB_XCNT(j)  (256  + 64 * (j))
#define XB_XSUB(j)  (1280 + 64 * (j))
#define XB_XGEN(j)  (2304 + 64 * (j))
#define XB_TOP      3328
#define XB_TOPGEN   3392
#define XCD_BAR_WORDS 3456
#define XB_SPIN_CAP (1u << 18)

__device__ __forceinline__ unsigned xb_ld(unsigned* p)              { return __hip_atomic_load(p, __ATOMIC_RELAXED, __HIP_MEMORY_SCOPE_AGENT); }
__device__ __forceinline__ unsigned xb_add(unsigned* p, unsigned v) { return __hip_atomic_fetch_add(p, v, __ATOMIC_RELAXED, __HIP_MEMORY_SCOPE_AGENT); }
__device__ __forceinline__ unsigned xb_xcc_id() { return (unsigned)__builtin_amdgcn_s_getreg((3 << 11) | 20) & 0xFu; }
#define XB_SPIN(cond, bar) do { unsigned _sp = 0; while (cond) { __builtin_amdgcn_s_sleep(1); \
    if ((++_sp & 255u) == 0u) { if (xb_ld(&(bar)[XB_TMO])) break; if (_sp > XB_SPIN_CAP) { atomicAdd(&(bar)[XB_TMO], 1u); break; } } } } while (0)

struct XcdBarrier {
    unsigned* bar; unsigned x;
    volatile LAS unsigned* st;
};

__device__ __forceinline__ XcdBarrier xcd_barrier_post(unsigned* bar, volatile LAS unsigned* st) {
    XcdBarrier b; b.bar = bar; b.x = xb_xcc_id(); b.st = st;
    if (threadIdx.x == 0) (void)xb_add(&bar[XB_XCNT(b.x)], 1u);
    return b;
}
__device__ __forceinline__ void xcd_barrier_complete(unsigned* bar, unsigned x, unsigned& nloc, unsigned& nx) {
    const unsigned G = gridDim.x * gridDim.y * gridDim.z;
    unsigned sum, cnt, mine, sp = 0u;
    for (;;) {
        sum = 0u; cnt = 0u; mine = 0u;
#pragma unroll
        for (unsigned j = 0; j < 16; ++j) { const unsigned c = xb_ld(&bar[XB_XCNT(j)]); sum += c; cnt += (c > 0u) ? 1u : 0u; mine = (j == x) ? c : mine; }
        if (sum == G) break;
        __builtin_amdgcn_s_sleep(1);
        if ((++sp & 255u) == 0u) { if (xb_ld(&bar[XB_TMO])) break; if (sp > XB_SPIN_CAP) { atomicAdd(&bar[XB_TMO], 1u); break; } }
    }
    nloc = mine > 0u ? mine : 1u; nx = cnt > 0u ? cnt : 1u;
}

__device__ __forceinline__ void xcd_barrier(const XcdBarrier& b) {
    asm volatile("s_waitcnt vmcnt(0)" ::: "memory");
    __syncthreads();
    if (threadIdx.x == 0) {
        unsigned* bar = b.bar;
        __builtin_amdgcn_s_waitcnt(0);
        unsigned nloc = b.st[0], nx = b.st[1];
        if (nloc == 0u) { xcd_barrier_complete(bar, b.x, nloc, nx); b.st[0] = nloc; b.st[1] = nx; }
        const unsigned old = xb_add(&bar[XB_XSUB(b.x)], 1u);
        const unsigned gen = old / nloc;
        if (old + 1u == (gen + 1u) * nloc) {
            __builtin_amdgcn_fence(__ATOMIC_RELEASE, "agent");
            asm volatile("s_waitcnt vmcnt(0)" ::: "memory");
            const unsigned og = xb_add(&bar[XB_TOP], 1u);
            const unsigned tg = og / nx;
            if (og + 1u == (tg + 1u) * nx) xb_add(&bar[XB_TOPGEN], 1u);
            else XB_SPIN(xb_ld(&bar[XB_TOPGEN]) == tg, bar);
            __builtin_amdgcn_fence(__ATOMIC_ACQUIRE, "agent");
            xb_add(&bar[XB_XGEN(b.x)], 1u);
            asm volatile("s_waitcnt vmcnt(0)" ::: "memory");
        } else {
            XB_SPIN(xb_ld(&bar[XB_XGEN(b.x)]) == gen, bar);
            __builtin_amdgcn_fence(__ATOMIC_ACQUIRE, "agent");
            asm volatile("s_waitcnt vmcnt(0)" ::: "memory");
        }
    }
    __syncthreads();
}


__device__ __forceinline__ float wave_sum(float v) {
#pragma unroll
    for (int o = 1; o < 64; o <<= 1) v += __shfl_xor(v, o);
    return v;
}
__device__ __forceinline__ float bf_lo(unsigned w) { return __builtin_bit_cast(float, w << 16); }
__device__ __forceinline__ float bf_hi(unsigned w) { return __builtin_bit_cast(float, w & 0xffff0000u); }
__device__ __forceinline__ void unpack8(const v4u w, float (&f)[8]) { f[0] = bf_lo(w.x); f[1] = bf_hi(w.x); f[2] = bf_lo(w.y); f[3] = bf_hi(w.y); f[4] = bf_lo(w.z); f[5] = bf_hi(w.z); f[6] = bf_lo(w.w); f[7] = bf_hi(w.w); }
__device__ __forceinline__ v4u pack8(const float (&f)[8]) { v4u w; w.x = pk2(f[0], f[1]); w.y = pk2(f[2], f[3]); w.z = pk2(f[4], f[5]); w.w = pk2(f[6], f[7]); return w; }

struct Frame {
    LAS unsigned char* lds;
    volatile LAS unsigned* MISC;
    gu32* ctl;
    int tid, lane, wave, vcu, G;
    const float* in[19]; float* out; unsigned char* ws;
};

__device__ __forceinline__ void p0_transpose_item(const float* W, int ldw, bf16* WT, int ldt, int row_off, const float* gain, LAS float* scr, int k0, int n0, int lane) {
#pragma unroll 8
    for (int i = 0; i < 32; ++i) { const int kk = 2 * i + (lane >> 5); float w = W[(size_t)(k0 + kk) * ldw + n0 + (lane & 31)]; if (gain) w *= gain[k0 + kk]; scr[kk * 33 + (lane & 31)] = w; }
    LDS_WAIT(); asm volatile("" ::: "memory");
    const int c = lane & 7;
#pragma unroll
    for (int j = 0; j < 4; ++j) { const int n = (lane >> 3) + 8 * j; const LAS float* s = scr + (8 * c) * 33 + n;
        v4u o; o.x = pk2(s[0 * 33], s[1 * 33]); o.y = pk2(s[2 * 33], s[3 * 33]); o.z = pk2(s[4 * 33], s[5 * 33]); o.w = pk2(s[6 * 33], s[7 * 33]);
        *(GAS v4u*)(WT + (size_t)(row_off + n0 + n) * ldt + k0 + 8 * c) = o; }
    LDS_WAIT(); asm volatile("" ::: "memory");
}
__device__ __forceinline__ void p0_fold_item(const float* wpool, const float* scale, const float* Wo, bf16* WT, int item, int lane) {
    const int g = item >> 6, ib = (item >> 5) & 1, nb = item & 31, i = ib * 64 + lane, n0 = nb * 32;
    const float* wp = wpool + ((size_t)g * 128 + i) * 128; const float* sc = scale + g * 128; const float* wo = Wo + (size_t)(512 + g * 128) * 1024 + n0;
    float o[32];
#pragma unroll
    for (int n = 0; n < 32; ++n) o[n] = 0.f;
    for (int d = 0; d < 128; d += 4) { const f32x4 w4 = *(const f32x4*)(wp + d);
#pragma unroll
        for (int dd = 0; dd < 4; ++dd) { const float a = w4[dd] * sc[d + dd]; const float* wr_ = wo + (size_t)(d + dd) * 1024;
#pragma unroll
            for (int n = 0; n < 32; ++n) o[n] += a * wr_[n]; } }
#pragma unroll
    for (int n = 0; n < 32; ++n) WT[(size_t)(n0 + n) * 1024 + 512 + g * 128 + i] = (bf16)f2bf(o[n]);
}
__device__ __forceinline__ void p0_prologue(Frame& F) {
    LAS float* scr = (LAS float*)(F.lds + RING_OFF + F.wave * 16384);
    const int gw = F.vcu * NWAVES + F.wave, NGW = F.G * NWAVES;
    bf16* Win0 = (bf16*)(F.ws + WS_WIN0); bf16* Wout0 = (bf16*)(F.ws + WS_WOUT0); bf16* Win1 = (bf16*)(F.ws + WS_WIN1); bf16* Wout1 = (bf16*)(F.ws + WS_WOUT1);
    bf16* Wgu0 = (bf16*)(F.ws + WS_WGU0); bf16* Wgu1 = (bf16*)(F.ws + WS_WGU1); bf16* Wd0 = (bf16*)(F.ws + WS_WD0); bf16* Wd1 = (bf16*)(F.ws + WS_WD1);
    constexpr int I_IN = 16 * 64, I_OA = 8 * 32, I_O1 = 16 * 32, I_GU = 16 * 88, I_D = 44 * 32, I_F = 256;
    constexpr int NITEMS = 2 * I_IN + I_OA + I_O1 + 4 * I_GU + 2 * I_D + I_F;
    for (int it = gw; it < NITEMS; it += NGW) {
        int r = it;
        if (r < I_F) { p0_fold_item(F.in[6], F.in[7], F.in[8], Wout0, r, F.lane); continue; } r -= I_F;
        if (r < I_IN) { p0_transpose_item(F.in[4], 2048, Win0, 1024, 0, F.in[1], scr, 64 * (r / 64), 32 * (r % 64), F.lane); continue; } r -= I_IN;
        if (r < I_IN) { p0_transpose_item(F.in[9], 2048, Win1, 1024, 0, F.in[1] + 1024, scr, 64 * (r / 64), 32 * (r % 64), F.lane); continue; } r -= I_IN;
        if (r < I_OA) { p0_transpose_item(F.in[8], 1024, Wout0, 1024, 0, nullptr, scr, 64 * (r / 32), 32 * (r % 32), F.lane); continue; } r -= I_OA;
        if (r < I_O1) { p0_transpose_item(F.in[13], 1024, Wout1, 1024, 0, nullptr, scr, 64 * (r / 32), 32 * (r % 32), F.lane); continue; } r -= I_O1;
        if (r < 4 * I_GU) { const int w = r / I_GU, rr = r % I_GU, l = w >> 1, isup = w & 1;
            p0_transpose_item((isup ? F.in[15] : F.in[14]) + (size_t)l * 1024 * DFF, DFF, l ? Wgu1 : Wgu0, 1024, isup * DFF, F.in[2] + l * 1024, scr, 64 * (rr / 88), 32 * (rr % 88), F.lane); continue; } r -= 4 * I_GU;
        { const int l = r / I_D, rr = r % I_D;
            p0_transpose_item(F.in[18] + (size_t)l * DFF * 1024, 1024, l ? Wd1 : Wd0, DFF, 0, nullptr, scr, 64 * (rr / 32), 32 * (rr % 32), F.lane); }
    }
    bf16* hb = (bf16*)(F.ws + WS_HB); float* part0 = (float*)(F.ws + WS_PART);
    for (int m = gw; m < M; m += NGW) {
        const GAS f32x4* xr = (const GAS f32x4*)(F.in[0] + (size_t)m * D) + F.lane;
        f32x4 v[4]; float s = 0.f;
#pragma unroll
        for (int j = 0; j < 4; ++j) { v[j] = xr[64 * j]; s += (v[j].x * v[j].x + v[j].y * v[j].y) + (v[j].z * v[j].z + v[j].w * v[j].w); }
        s = wave_sum(s);
        GAS unsigned long long* o8 = (GAS unsigned long long*)(hb + (size_t)m * D) + F.lane;
#pragma unroll
        for (int j = 0; j < 4; ++j) o8[64 * j] = (unsigned long long)pk2(v[j].x, v[j].y) | ((unsigned long long)pk2(v[j].z, v[j].w) << 32);
        if (F.lane < 16) part0[(size_t)m * 16 + F.lane] = F.lane == 0 ? s : 0.f;
    }
}

__device__ __forceinline__ void mixer0_phase(Frame& F) {
    const bf16* proj = (const bf16*)(F.ws + WS_PROJ); bf16* mix = (bf16*)(F.ws + WS_MIX);
    const int gw = F.vcu * NWAVES + F.wave, NGW = F.G * NWAVES, o = F.lane;
    for (int it = gw; it < 2 * (M / RUN); it += NGW) {
        const int run = it >> 1, half = it & 1, t0 = run * RUN; const bool seq_start = (t0 % SEQ) == 0;
        if (half == 0) {
            float w0[8], w1[8], w2[8], c1[8], c2[8];
#pragma unroll
            for (int e = 0; e < 8; ++e) { w0[e] = F.in[5][8 * o + e]; w1[e] = F.in[5][512 + 8 * o + e]; w2[e] = F.in[5][1024 + 8 * o + e]; c1[e] = 0.f; c2[e] = 0.f; }
            if (!seq_start) { float a[8], b[8];
                unpack8(*(const GAS v4u*)(proj + (size_t)(t0 - 2) * EVEN_IN + 512 + 8 * o), a); unpack8(*(const GAS v4u*)(proj + (size_t)(t0 - 2) * EVEN_IN + 1024 + 8 * o), b);
#pragma unroll
                for (int e = 0; e < 8; ++e) c2[e] = a[e] * b[e];
                unpack8(*(const GAS v4u*)(proj + (size_t)(t0 - 1) * EVEN_IN + 512 + 8 * o), a); unpack8(*(const GAS v4u*)(proj + (size_t)(t0 - 1) * EVEN_IN + 1024 + 8 * o), b);
#pragma unroll
                for (int e = 0; e < 8; ++e) c1[e] = a[e] * b[e]; }
#pragma unroll 4
            for (int t = 0; t < RUN; ++t) { const bf16* pr = proj + (size_t)(t0 + t) * EVEN_IN + 8 * o; float ab[8], ac[8], av[8], y[8];
                unpack8(*(const GAS v4u*)(pr), ab); unpack8(*(const GAS v4u*)(pr + 512), ac); unpack8(*(const GAS v4u*)(pr + 1024), av);
#pragma unroll
                for (int e = 0; e < 8; ++e) { const float c0 = ac[e] * av[e]; y[e] = ab[e] * (w0[e] * c2[e] + w1[e] * c1[e] + w2[e] * c0); c2[e] = c1[e]; c1[e] = c0; }
                *(GAS v4u*)(mix + (size_t)(t0 + t) * D + 8 * o) = pack8(y); }
        } else {
            const int w = 2 << (o >> 4); const bf16* zb = proj + 1536 + 8 * o; float S[8];
#pragma unroll
            for (int e = 0; e < 8; ++e) S[e] = 0.f;
            if (!seq_start) { for (int j = 1; j < 16; ++j) if (j < w) { float z[8]; unpack8(*(const GAS v4u*)(zb + (size_t)(t0 - j) * EVEN_IN), z);
#pragma unroll
                    for (int e = 0; e < 8; ++e) S[e] += z[e]; } }
#pragma unroll 4
            for (int t = 0; t < RUN; ++t) { const int tl = (t0 + t) % SEQ; float z[8], y[8]; unpack8(*(const GAS v4u*)(zb + (size_t)(t0 + t) * EVEN_IN), z);
                const float rc = 1.0f / (float)min(tl + 1, w);
#pragma unroll
                for (int e = 0; e < 8; ++e) { S[e] += z[e]; y[e] = S[e] * rc - z[e]; }
                *(GAS v4u*)(mix + (size_t)(t0 + t) * D + 512 + 8 * o) = pack8(y);
                if (tl - w + 1 >= 0) { float zo[8]; unpack8(*(const GAS v4u*)(zb + (size_t)(t0 + t - w + 1) * EVEN_IN), zo);
#pragma unroll
                    for (int e = 0; e < 8; ++e) S[e] -= zo[e]; } }
        }
    }
}

__device__ __forceinline__ void act_phase(Frame& F, int layer) {
    const bf16* g = (const bf16*)(F.ws + WS_G); bf16* up = (bf16*)(F.ws + WS_UP);
    const float* cw = F.in[16] + (size_t)layer * 3 * DFF; const float* cb = F.in[17] + (size_t)layer * DFF;
    const int gt = F.vcu * NWAVES * 64 + F.tid, NGT = F.G * NWAVES * 64; constexpr int NOCT = DFF / 8, NIT = NOCT * (M / RUN);
    for (int it = gt; it < NIT; it += NGT) {
        const int run = it / NOCT, o = it % NOCT, t0 = run * RUN; const bool seq_start = (t0 % SEQ) == 0;
        float w0[8], w1[8], w2[8], b[8], g1[8], g2[8];
#pragma unroll
        for (int e = 0; e < 8; ++e) { w0[e] = cw[8 * o + e]; w1[e] = cw[DFF + 8 * o + e]; w2[e] = cw[2 * DFF + 8 * o + e]; b[e] = cb[8 * o + e]; g1[e] = 0.f; g2[e] = 0.f; }
        if (!seq_start) { unpack8(*(const GAS v4u*)(g + (size_t)(t0 - 2) * DFF + 8 * o), g2); unpack8(*(const GAS v4u*)(g + (size_t)(t0 - 1) * DFF + 8 * o), g1); }
#pragma unroll 4
        for (int t = 0; t < RUN; ++t) { const size_t off = (size_t)(t0 + t) * DFF + 8 * o; float g0[8], u[8], y[8];
            unpack8(*(const GAS v4u*)(g + off), g0); unpack8(*(const GAS v4u*)(up + off), u);
#pragma unroll
            for (int e = 0; e < 8; ++e) { const float a = w0[e] * g2[e] + w1[e] * g1[e] + w2[e] * g0[e] + b[e]; y[e] = a * __builtin_amdgcn_rcpf(1.0f + __expf(-a)) * u[e]; g2[e] = g1[e]; g1[e] = g0[e]; }
            *(GAS v4u*)(up + off) = pack8(y); }
    }
}

constexpr int VT_PITCH = 136;
__device__ __forceinline__ void sgu_phase(Frame& F) {
    const bf16* proj = (const bf16*)(F.ws + WS_PROJ); bf16* mix = (bf16*)(F.ws + WS_MIX); const float* vpart = (const float*)(F.ws + WS_PART + 3 * PART_BYTES);
    LAS bf16* vT = (LAS bf16*)(F.lds + RING_OFF); LAS float* rvs = (LAS float*)(F.lds + RING_OFF + 128 * VT_PITCH * 2);
    const int h = blockIdx.x & 7, fr = F.lane & 15, fq = F.lane >> 4, wv = F.wave, t = 16 * wv + fr;
    pg8::bf16x8 wsf[4];
#pragma unroll
    for (int ks = 0; ks < 4; ++ks) { const float* wp = F.in[11] + ((size_t)h * 128 + t) * 128 + 32 * ks + 8 * fq; const f32x4 a = *(const f32x4*)wp, b = *(const f32x4*)(wp + 4); const int s0 = 32 * ks + 8 * fq;
        float f[8] = {a[0], a[1], a[2], a[3], b[0], b[1], b[2], b[3]};
#pragma unroll
        for (int e = 0; e < 8; ++e) if (s0 + e > t) f[e] = 0.f;
        const v4u w = pack8(f); wsf[ks] = __builtin_bit_cast(pg8::bf16x8, w); }
    const float bias = F.in[12][h * 128 + t];
    for (int i = 0; i < 8; ++i) { const int q = (blockIdx.x >> 3) + 32 * i; if (q >= M / 128) break; const int m0 = q * 128;
        if (F.tid < 128) rvs[F.tid] = pg8::rinv_from_part(vpart, m0 + F.tid);
        LDS_WAIT(); __syncthreads();
#pragma unroll
        for (int p = 0; p < 4; ++p) { const int pc = F.tid + 512 * p, s = pc >> 4, c8 = (pc & 15) * 8; float f[8];
            unpack8(*(const GAS v4u*)(proj + (size_t)(m0 + s) * EVEN_IN + 1024 + h * 128 + c8), f); const float r = rvs[s];
#pragma unroll
            for (int e = 0; e < 8; ++e) vT[(c8 + e) * VT_PITCH + s] = (bf16)f2bf(f[e] * r); }
        LDS_WAIT(); __syncthreads();
#pragma unroll
        for (int p = 0; p < 4; ++p) { pg8::f32x4 a0 = {0.f, 0.f, 0.f, 0.f}, a1 = {0.f, 0.f, 0.f, 0.f};
            const int cr = 32 * p + 8 * (fr >> 2) + (fr & 3);
#pragma unroll
            for (int ks = 0; ks < 4; ++ks) { const pg8::bf16x8 v0 = *(const LAS pg8::bf16x8*)(vT + cr * VT_PITCH + 32 * ks + 8 * fq), v1 = *(const LAS pg8::bf16x8*)(vT + (cr + 4) * VT_PITCH + 32 * ks + 8 * fq);
                a0 = __builtin_amdgcn_mfma_f32_16x16x32_bf16(v0, wsf[ks], a0, 0, 0, 0); a1 = __builtin_amdgcn_mfma_f32_16x16x32_bf16(v1, wsf[ks], a1, 0, 0, 0); }
            const int ch = h * 128 + 32 * p + 8 * fq; const size_t row = (size_t)(m0 + t); float u[8], y[8];
            unpack8(*(const GAS v4u*)(proj + row * EVEN_IN + ch), u); const f32x4 s0 = *(const f32x4*)(F.in[10] + ch), s1 = *(const f32x4*)(F.in[10] + ch + 4);
#pragma unroll
            for (int e = 0; e < 4; ++e) { y[e] = u[e] * (s0[e] * a0[e] + bias); y[4 + e] = u[4 + e] * (s1[e] * a1[e] + bias); }
            *(GAS v4u*)(mix + row * D + ch) = pack8(y); }
        __syncthreads();
    }
}

__device__ __forceinline__ void final_phase(Frame& F) {
    const float* h4 = (const float*)(F.ws + WS_H4); const int gw = F.vcu * NWAVES + F.wave, NGW = F.G * NWAVES;
    f32x4 gf[4];
#pragma unroll
    for (int j = 0; j < 4; ++j) gf[j] = ((const f32x4*)F.in[3])[F.lane + 64 * j];
    for (int m = gw; m < M; m += NGW) {
        const GAS f32x4* xr = (const GAS f32x4*)(h4 + (size_t)m * D) + F.lane; f32x4 v[4]; float s = 0.f;
#pragma unroll
        for (int j = 0; j < 4; ++j) { v[j] = xr[64 * j]; s += (v[j].x * v[j].x + v[j].y * v[j].y) + (v[j].z * v[j].z + v[j].w * v[j].w); }
        const float ri = 1.0f / sqrtf(wave_sum(s) * (1.0f / D) + pg8::RMS_EPS);
        GAS f32x4* o = (GAS f32x4*)(F.out + (size_t)m * D) + F.lane;
#pragma unroll
        for (int j = 0; j < 4; ++j) o[64 * j] = v[j] * ri * gf[j];
    }
}

struct Args { const float* in[19]; float* out; unsigned char* ws; int ph_lo, ph_hi, li, pad; };
__global__ void __launch_bounds__(NWAVES * 64, 2) trunk_fwd(Args args) {
    extern __shared__ __attribute__((aligned(16))) unsigned char lds[];
    Frame F;
    F.lds = (LAS unsigned char*)lds; F.MISC = (volatile LAS unsigned*)(F.lds + MISC_OFF);
    F.tid = threadIdx.x; F.lane = F.tid & 63; F.wave = __builtin_amdgcn_readfirstlane(F.tid >> 6);
    F.G = gridDim.x; { const int bx = blockIdx.x; F.vcu = (F.G % 8 == 0) ? (bx % 8) * (F.G / 8) + bx / 8 : bx; }
#pragma unroll
    for (int i = 0; i < 19; ++i) F.in[i] = args.in[i];
    F.out = args.out; F.ws = args.ws; F.ctl = (gu32*)(args.ws + WS_CTL);
    for (int u = F.tid; u < (LDS_BYTES - LDSCTL_OFF) / 4; u += NWAVES * 64) ((LAS unsigned*)(F.lds + LDSCTL_OFF))[u] = 0u;
    __syncthreads();
    XcdBarrier bar; bar.bar = (unsigned*)(F.ctl + CW_BAR); bar.x = 0; bar.st = nullptr;
    if (!MK_PER_PHASE) bar = xcd_barrier_post((unsigned*)(F.ctl + CW_BAR), F.MISC + 8);
    const int lo = args.ph_lo, hi = args.ph_hi;
#define IN(k) (lo <= (k) && (k) < hi)
#define SEAM(k) do { if (IN(k) && IN((k) + 1)) xcd_barrier(bar); } while (0)
    unsigned char* ws = args.ws;
    bf16* HB = (bf16*)(ws + WS_HB); bf16* PROJ = (bf16*)(ws + WS_PROJ); bf16* MIX = (bf16*)(ws + WS_MIX); bf16* GB = (bf16*)(ws + WS_G); bf16* UP = (bf16*)(ws + WS_UP);
    float* PART = (float*)(ws + WS_PART); float* H4 = (float*)(ws + WS_H4);
    using pg8::Gemm; using pg8::StaticOrder;
    typedef pg8::EpiProj<0, false> EP0; typedef pg8::EpiProj<1, true> EP1; typedef pg8::EpiResid<true> ER1; typedef pg8::EpiResid<false> ER0;
    const int c = (int)blockIdx.x;

    if (IN(0)) { p0_prologue(F); } SEAM(0);
    if (IN(1)) {
        Gemm g{HB, (const bf16*)(ws + WS_WIN0), M, EVEN_IN, D}; StaticOrder S; S.init(M, EVEN_IN, F.G, c);
        EP0 E{PROJ, EVEN_IN, 0, 0, PART, nullptr, 0};
        pg8::gemm_phase<EP0, StaticOrder, true, true>(F.lds + RING_OFF, g, S, E); } SEAM(1);
    if (IN(2)) { mixer0_phase(F); } SEAM(2);
    if (IN(3)) {
        Gemm g{MIX, (const bf16*)(ws + WS_WOUT0), M, D, D}; StaticOrder S; S.init(M, D, F.G, c);
        ER1 E{F.in[0], F.out, HB, PART + 1 * (size_t)M * 16};
        pg8::gemm_phase<ER1, StaticOrder, true, true>(F.lds + RING_OFF, g, S, E); } SEAM(3);
    if (IN(4)) {
        Gemm g{HB, (const bf16*)(ws + WS_WGU0), M, NGU, D}; StaticOrder S; S.init(M, NGU, F.G, c);
        EP0 E{GB, DFF, DFF, (size_t)(WS_UP - WS_G) / 2, PART + 1 * (size_t)M * 16, nullptr, 0};
        pg8::gemm_phase<EP0, StaticOrder, true, true>(F.lds + RING_OFF, g, S, E); } SEAM(4);
    if (IN(5)) { act_phase(F, 0); } SEAM(5);
    if (IN(6)) {
        Gemm g{UP, (const bf16*)(ws + WS_WD0), M, D, DFF}; StaticOrder S; S.init(M, D, F.G, c);
        ER1 E{F.out, F.out, HB, PART + 2 * (size_t)M * 16};
        pg8::gemm_phase<ER1, StaticOrder, true, true>(F.lds + RING_OFF, g, S, E); } SEAM(6);
    if (IN(7)) {
        Gemm g{HB, (const bf16*)(ws + WS_WIN1), M, EVEN_IN, D}; StaticOrder S; S.init(M, EVEN_IN, F.G, c);
        EP1 E{PROJ, EVEN_IN, 0, 0, PART + 2 * (size_t)M * 16, PART + 3 * (size_t)M * 16, 4};
        pg8::gemm_phase<EP1, StaticOrder, true, true>(F.lds + RING_OFF, g, S, E); } SEAM(7);
    if (IN(8)) { sgu_phase(F); } SEAM(8);
    if (IN(9)) {
        Gemm g{MIX, (const bf16*)(ws + WS_WOUT1), M, D, D}; StaticOrder S; S.init(M, D, F.G, c);
        ER1 E{F.out, F.out, HB, PART + 4 * (size_t)M * 16};
        pg8::gemm_phase<ER1, StaticOrder, true, true>(F.lds + RING_OFF, g, S, E); } SEAM(9);
    if (IN(10)) {
        Gemm g{HB, (const bf16*)(ws + WS_WGU1), M, NGU, D}; StaticOrder S; S.init(M, NGU, F.G, c);
        EP0 E{GB, DFF, DFF, (size_t)(WS_UP - WS_G) / 2, PART + 4 * (size_t)M * 16, nullptr, 0};
        pg8::gemm_phase<EP0, StaticOrder, true, true>(F.lds + RING_OFF, g, S, E); } SEAM(10);
    if (IN(11)) { act_phase(F, 1); } SEAM(11);
    if (IN(12)) {
        Gemm g{UP, (const bf16*)(ws + WS_WD1), M, D, DFF}; StaticOrder S; S.init(M, D, F.G, c);
        ER0 E{F.out, H4, nullptr, nullptr};
        pg8::gemm_phase<ER0, StaticOrder, true, true>(F.lds + RING_OFF, g, S, E); } SEAM(12);
    if (IN(13)) { final_phase(F); }
#undef IN
#undef SEAM
}

extern "C" void kernel_launch(void* const* d_in, const int* in_sizes, int n_in, void* d_out, int out_size, void* d_ws, size_t ws_size, hipStream_t stream) {
    static int grid = 0;
    if (grid == 0) {
        if (n_in != 19 || in_sizes[0] != M * D || out_size != M * D || ws_size < WS_END) { fprintf(stderr, "kernel_launch: unexpected shapes: n_in %d in0 %d out %d ws %zu (need %zu)\n", n_in, n_in > 0 ? in_sizes[0] : -1, out_size, ws_size, (size_t)WS_END); grid = -1; return; }
        int dev = 0, cus = 0, per_cu = 0;
        if (hipGetDevice(&dev) != hipSuccess || hipDeviceGetAttribute(&cus, hipDeviceAttributeMultiprocessorCount, dev) != hipSuccess) { fprintf(stderr, "kernel_launch: device query failed\n"); grid = -1; return; }
        if (hipFuncSetAttribute((const void*)trunk_fwd, hipFuncAttributeMaxDynamicSharedMemorySize, LDS_BYTES) != hipSuccess) { fprintf(stderr, "kernel_launch: hipFuncSetAttribute failed\n"); grid = -1; return; }
        if (hipOccupancyMaxActiveBlocksPerMultiprocessor(&per_cu, (const void*)trunk_fwd, NWAVES * 64, LDS_BYTES) != hipSuccess || per_cu < 1) { fprintf(stderr, "kernel_launch: occupancy query says %d blocks per CU\n", per_cu); }
        (void)hipGetLastError();
        grid = cus;
        if (grid != 256) fprintf(stderr, "kernel_launch: note: %d CUs\n", grid);
    }
    if (grid < 0) return;
    (void)hipMemsetAsync((char*)d_ws + WS_CTL, 0, CTL_ZERO_BYTES, stream);
    Args a{};
    for (int i = 0; i < 19; ++i) a.in[i] = (const float*)d_in[i];
    a.out = (float*)d_out; a.ws = (unsigned char*)d_ws;
#if MK_PER_PHASE
    for (int li = 0; li < NPHASE; ++li) { a.ph_lo = li; a.ph_hi = li + 1; a.li = li; hipLaunchKernelGGL(trunk_fwd, dim3(grid), dim3(NWAVES * 64), LDS_BYTES, stream, a); }
#else
    a.ph_lo = 0; a.ph_hi = NPHASE; a.li = 0;
    hipLaunchKernelGGL(trunk_fwd, dim3(grid), dim3(NWAVES * 64), LDS_BYTES, stream, a);
#endif
    const hipError_t le = hipPeekAtLastError();
    if (le != hipSuccess) fprintf(stderr, "kernel_launch: launch failed: %s\n", hipGetErrorName(le));
}
```

```cpp
#include <hip/hip_runtime.h>
#include <cstdio>
#include <cstdint>
#ifndef PG8_PROBE_EPI
#define PG8_PROBE_EPI 0
#endif
namespace pg8 {
#define PG8_LAS __attribute__((address_space(3)))
typedef unsigned short bf16_t;
typedef short bf16x8 __attribute__((ext_vector_type(8)));
typedef float f32x4 __attribute__((ext_vector_type(4)));
typedef unsigned u32x4 __attribute__((ext_vector_type(4)));
constexpr int BM = 256, BK = 64, HALF = 128, HTB = HALF * BK * 2  , STAGE_BYTES = 8 * HTB, NXCD = 8, WGM = 8;

__host__ __device__ __forceinline__ int lds_byte(int r, int c) { const int st = (r >> 4) * 2 + (c >> 5), rr = r & 15, cc = c & 31, ob = rr * 64 + cc * 2; return st * 1024 + (ob ^ (((ob >> 9) & 1) << 5)); }
__host__ __device__ __forceinline__ void stage_rc(int b, int& R, int& C) { const int st = b / 1024, sb = b % 1024, swz = sb ^ (((sb >> 9) & 1) << 5); R = (st >> 1) * 16 + swz / 64; C = (st & 1) * 32 + (swz % 64) / 2; }
__host__ __device__ __forceinline__ int perm32(int rho) { const int n = rho >> 4, i = rho & 15; return 8 * (i >> 2) + 4 * n + (i & 3); }

struct Unit { int pm, pn, pass; };
struct Gemm { const bf16_t* A; const bf16_t* Bt; int M, N, K; };

struct StaticOrder {
    int nM, nN, nwg, G, c, rep, noepi;
    __host__ __device__ void init(int M, int N, int G_, int c_, int rep_ = 1, int noepi_ = 0) { nM = M / BM; nN = N / BM; nwg = nM * nN; G = G_; c = c_; rep = rep_; noepi = noepi_; }
    __host__ __device__ bool live(int i) const { return !(noepi && i >= (nwg + G - 1) / G && (noepi == 1 || ((c >> 3) & 1))); }
    __host__ __device__ bool next(int i, Unit& u) const {
        const int rounds = (nwg + G - 1) / G; if (i >= rounds * rep) return false; const long L = (long)(i % rounds) * G + c; if (L >= nwg) return false;
        int wgid = (int)L; { const int q = nwg / NXCD, r = nwg % NXCD, xcd = wgid % NXCD, off = wgid / NXCD; wgid = (xcd < r ? xcd * (q + 1) : r * (q + 1) + (xcd - r) * q) + off; }
        const int nig = WGM * nN, gid = wgid / nig, fm = gid * WGM, gsz = (nM - fm) < WGM ? (nM - fm) : WGM;
        u.pm = fm + ((wgid % nig) % gsz); u.pn = (wgid % nig) / gsz; u.pass = i >= rounds; return true;
    }
    __device__ __forceinline__ void a_ready(const Unit&) const {}
    __device__ __forceinline__ void done(const Unit&) const {}
};

__device__ __forceinline__ unsigned cvt_pk_bf16(float lo, float hi) { unsigned r; asm volatile("v_cvt_pk_bf16_f32 %0, %1, %2" : "=v"(r) : "v"(lo), "v"(hi)); return r; }
typedef float f32x2 __attribute__((ext_vector_type(2)));
__device__ __forceinline__ f32x2 gelu_pk(f32x2 v) {
    const f32x2 av = __builtin_elementwise_abs(v), d = av * 0.2316418882f + 1.0f;
    f32x2 t; t.x = __builtin_amdgcn_rcpf(d.x); t.y = __builtin_amdgcn_rcpf(d.y);
    f32x2 q = t * 0.5307027145f + (-0.7265760135f); q = q * t + 0.7107068705f; q = q * t + (-0.142248368f); q = q * t + 0.127414796f; q = q * t;
    const f32x2 s = (v * v) * (-0.72134752044f);
    f32x2 e; e.x = __builtin_amdgcn_exp2f(s.x); e.y = __builtin_amdgcn_exp2f(s.y);
    return __builtin_elementwise_max(v, (f32x2){0.f, 0.f}) - av * (q * e);
}

constexpr float RMS_EPS = 1e-6f;
__device__ __forceinline__ float rinv_of(const f32x4 p) { return 1.0f / sqrtf(((p[0] + p[1]) + (p[2] + p[3])) * (1.0f / 1024.0f) + RMS_EPS); }
__device__ __forceinline__ float rinv_from_part(const float* part, int row) { return rinv_of(*(const f32x4*)(part + (size_t)row * 4)); }
__device__ __forceinline__ float gelu_erf(float v) { return 0.5f * v * (1.0f + erff(v * 0.70710678118654752f)); }
__device__ __forceinline__ float sumsq8(const f32x4 a, const f32x4 b) { return ((a[0] * a[0] + a[1] * a[1]) + (a[2] * a[2] + a[3] * a[3])) + ((b[0] * b[0] + b[1] * b[1]) + (b[2] * b[2] + b[3] * b[3])); }
#define EPI_LDS_BARRIER() do { asm volatile("s_waitcnt lgkmcnt(0)" ::: "memory"); __builtin_amdgcn_s_barrier(); asm volatile("" ::: "memory"); } while (0)
__device__ __forceinline__ void tile_rowsum_publish(const float (&ss)[2][4], PG8_LAS float* red, float* part_out, int pm, int slot, int wr, int wc, int fr, int fq) {
    if (fq == 0) {
#pragma unroll
        for (int ai = 0; ai < 2; ++ai)
#pragma unroll
            for (int m = 0; m < 4; ++m) red[(ai * HALF + wr * 64 + m * 16 + fr) * 4 + wc] = ss[ai][m]; }
    EPI_LDS_BARRIER();
    if (wr == 0) { const int row = wc * 64 + fq * 16 + fr; const f32x4 p = *(const PG8_LAS f32x4*)(red + row * 4); part_out[(size_t)(pm * BM + row) * 4 + slot] = (p[0] + p[1]) + (p[2] + p[3]); }
}

template <int ACT, bool VSS> struct EpiProj {
    static constexpr bool PERM = true, AFTER_DRAIN = false;
    __device__ __forceinline__ void prefetch(const Unit&, int, int) const {}
    bf16_t* O; int ldc; const PG8_LAS float* rtab; float* pout; int pn0; PG8_LAS float* red;
    __device__ __forceinline__ void operator()(const f32x4 (&acc)[2][2][4][2], const Unit& u, int wr, int wc, int fr, int fq) const {
        const int row0 = u.pm * BM + wr * 64 + fr, col0 = u.pn * BM + wc * 32 + 8 * fq;
        float ri[2][4], ss[2][4];
#pragma unroll
        for (int ai = 0; ai < 2; ++ai)
#pragma unroll
            for (int m = 0; m < 4; ++m) ri[ai][m] = rtab[((u.pm >> 3) & 1) * 256 + ai * HALF + wr * 64 + m * 16 + fr];
#pragma unroll
        for (int ai = 0; ai < 2; ++ai)
#pragma unroll
            for (int m = 0; m < 4; ++m) { const int row = row0 + ai * HALF + m * 16; const float r = ri[ai][m];
                bf16_t* rowp = O + (size_t)row * ldc + col0; float s = 0.f;
#pragma unroll
                for (int bj = 0; bj < 2; ++bj) { f32x4 v0 = acc[ai][bj][m][0] * r, v1 = acc[ai][bj][m][1] * r;
                    if (ACT == 1) { const f32x2 a = gelu_pk((f32x2){v0[0], v0[1]}), b = gelu_pk((f32x2){v0[2], v0[3]}), c = gelu_pk((f32x2){v1[0], v1[1]}), d = gelu_pk((f32x2){v1[2], v1[3]});
                        v0 = (f32x4){a.x, a.y, b.x, b.y}; v1 = (f32x4){c.x, c.y, d.x, d.y}; }
                    if (VSS) s += sumsq8(v0, v1);
                    u32x4 w; w.x = cvt_pk_bf16(v0[0], v0[1]); w.y = cvt_pk_bf16(v0[2], v0[3]); w.z = cvt_pk_bf16(v1[0], v1[1]); w.w = cvt_pk_bf16(v1[2], v1[3]);
                    *(u32x4*)(rowp + bj * HALF) = w; }
                if (VSS) { s += __shfl_xor(s, 16); s += __shfl_xor(s, 32); ss[ai][m] = s; } }
        if (VSS) { if (u.pn >= pn0) tile_rowsum_publish(ss, red, pout, u.pm, u.pn - pn0, wr, wc, fr, fq); }
    }
};

__device__ __forceinline__ void bf8_to_f32(const u32x4 w, f32x4& lo, f32x4& hi) {
    lo[0] = __builtin_bit_cast(float, w.x << 16); lo[1] = __builtin_bit_cast(float, w.x & 0xffff0000u); lo[2] = __builtin_bit_cast(float, w.y << 16); lo[3] = __builtin_bit_cast(float, w.y & 0xffff0000u);
    hi[0] = __builtin_bit_cast(float, w.z << 16); hi[1] = __builtin_bit_cast(float, w.z & 0xffff0000u); hi[2] = __builtin_bit_cast(float, w.w << 16); hi[3] = __builtin_bit_cast(float, w.w & 0xffff0000u);
}
template <bool FINAL> struct EpiResid {
    static constexpr bool PERM = true, AFTER_DRAIN = false;
    bf16_t* hb; float* out; float* pout; PG8_LAS float* red;
    __device__ __forceinline__ void prefetch(const Unit&, int, int) const {}
    __device__ __forceinline__ void operator()(const f32x4 (&acc)[2][2][4][2], const Unit& u, int wr, int wc, int fr, int fq) const {
        const int row0 = u.pm * BM + wr * 64 + fr, col0 = u.pn * BM + wc * 32 + 8 * fq; float ss[2][4];
#pragma unroll
        for (int ai = 0; ai < 2; ++ai) {
            u32x4 b[4][2];
#pragma unroll
            for (int m = 0; m < 4; ++m)
#pragma unroll
                for (int bj = 0; bj < 2; ++bj) b[m][bj] = *(const u32x4*)(hb + (size_t)(row0 + ai * HALF + m * 16) * 1024 + col0 + bj * HALF);
#pragma unroll
            for (int m = 0; m < 4; ++m) { const size_t off = (size_t)(row0 + ai * HALF + m * 16) * 1024 + col0; float s = 0.f;
#pragma unroll
                for (int bj = 0; bj < 2; ++bj) { f32x4 b0, b1; bf8_to_f32(b[m][bj], b0, b1); const f32x4 h0 = b0 + acc[ai][bj][m][0], h1 = b1 + acc[ai][bj][m][1];
                    if (FINAL) { *(f32x4*)(out + off + bj * HALF) = h0; *(f32x4*)(out + off + bj * HALF + 4) = h1; }
                    else { s += sumsq8(h0, h1);
                        u32x4 w; w.x = cvt_pk_bf16(h0[0], h0[1]); w.y = cvt_pk_bf16(h0[2], h0[3]); w.z = cvt_pk_bf16(h1[0], h1[1]); w.w = cvt_pk_bf16(h1[2], h1[3]);
                        *(u32x4*)(hb + off + bj * HALF) = w; } }
                if (!FINAL) { s += __shfl_xor(s, 16); s += __shfl_xor(s, 32); ss[ai][m] = s; } }
            asm volatile("" ::: "memory"); }
        if (!FINAL) tile_rowsum_publish(ss, red, pout, u.pm, u.pn, wr, wc, fr, fq);
    }
};

struct EpiFinal {
    static constexpr bool PERM = true, AFTER_DRAIN = false;
    const bf16_t* hb; float* out; float* xsum; unsigned* cnt; const float* gain; PG8_LAS float* red;
    __device__ __forceinline__ void prefetch(const Unit&, int, int) const {}
    __device__ __forceinline__ void operator()(f32x4 (&acc)[2][2][4][2], const Unit& u, int wr, int wc, int fr_, int fq_) const {
        int fr = fr_, fq = fq_; asm volatile("" : "+v"(fr), "+v"(fq));
        const int row0 = u.pm * BM + wr * 64 + fr, col0 = u.pn * BM + wc * 32 + 8 * fq; float ss[2][4];
#pragma unroll
        for (int ai = 0; ai < 2; ++ai) { u32x4 b[4][2];
#pragma unroll
            for (int m = 0; m < 4; ++m)
#pragma unroll
                for (int bj = 0; bj < 2; ++bj) b[m][bj] = *(const u32x4*)(hb + (size_t)(row0 + ai * HALF + m * 16) * 1024 + col0 + bj * HALF);
#pragma unroll
            for (int m = 0; m < 4; ++m) { float s = 0.f;
#pragma unroll
                for (int bj = 0; bj < 2; ++bj) { f32x4 b0, b1; bf8_to_f32(b[m][bj], b0, b1); acc[ai][bj][m][0] += b0; acc[ai][bj][m][1] += b1; s += sumsq8(acc[ai][bj][m][0], acc[ai][bj][m][1]); }
                s += __shfl_xor(s, 16); s += __shfl_xor(s, 32); ss[ai][m] = s; }
            asm volatile("" ::: "memory"); }
        if (fq == 0) {
#pragma unroll
            for (int ai = 0; ai < 2; ++ai)
#pragma unroll
                for (int m = 0; m < 4; ++m) red[(ai * HALF + wr * 64 + m * 16 + fr) * 4 + wc] = ss[ai][m]; }
        EPI_LDS_BARRIER();
        const int trow = wc * 64 + fq * 16 + fr;
        if (wr == 0) { const f32x4 p = *(const PG8_LAS f32x4*)(red + trow * 4);
            __hip_atomic_store(xsum + (size_t)(u.pm * BM + trow) * 4 + u.pn, (p[0] + p[1]) + (p[2] + p[3]), __ATOMIC_RELAXED, __HIP_MEMORY_SCOPE_AGENT); }
        asm volatile("s_waitcnt vmcnt(0)" ::: "memory");
        EPI_LDS_BARRIER();
        if (wr == 0 && wc == 0 && fq == 0 && fr == 0) {
            __hip_atomic_fetch_add(cnt + 64 * u.pm, 1u, __ATOMIC_RELAXED, __HIP_MEMORY_SCOPE_AGENT);
            unsigned spins = 0;
            while (__hip_atomic_load(cnt + 64 * u.pm, __ATOMIC_RELAXED, __HIP_MEMORY_SCOPE_AGENT) < 4u) { __builtin_amdgcn_s_sleep(2); if (++spins > (1u << 22)) break; }
        }
        EPI_LDS_BARRIER();
        if (wr == 0) { const float* xs = xsum + (size_t)(u.pm * BM + trow) * 4;
            const float p0 = __hip_atomic_load(xs, __ATOMIC_RELAXED, __HIP_MEMORY_SCOPE_AGENT), p1 = __hip_atomic_load(xs + 1, __ATOMIC_RELAXED, __HIP_MEMORY_SCOPE_AGENT),
                        p2 = __hip_atomic_load(xs + 2, __ATOMIC_RELAXED, __HIP_MEMORY_SCOPE_AGENT), p3 = __hip_atomic_load(xs + 3, __ATOMIC_RELAXED, __HIP_MEMORY_SCOPE_AGENT);
            red[1024 + trow] = rinv_of((f32x4){p0, p1, p2, p3}); }
        EPI_LDS_BARRIER();
        f32x4 g[2][2];
#pragma unroll
        for (int bj = 0; bj < 2; ++bj) { g[bj][0] = *(const f32x4*)(gain + col0 + bj * HALF); g[bj][1] = *(const f32x4*)(gain + col0 + bj * HALF + 4); }
#pragma unroll
        for (int ai = 0; ai < 2; ++ai) {
#pragma unroll
            for (int m = 0; m < 4; ++m) { const size_t off = (size_t)(row0 + ai * HALF + m * 16) * 1024 + col0; const float r = red[1024 + ai * HALF + wr * 64 + m * 16 + fr];
#pragma unroll
                for (int bj = 0; bj < 2; ++bj) {
                    __builtin_nontemporal_store(acc[ai][bj][m][0] * r * g[bj][0], (f32x4*)(out + off + bj * HALF));
                    __builtin_nontemporal_store(acc[ai][bj][m][1] * r * g[bj][1], (f32x4*)(out + off + bj * HALF + 4)); } }
            asm volatile("" ::: "memory"); }
    }
};

__device__ __forceinline__ float dpp_ror1(float v) { return __builtin_bit_cast(float, __builtin_amdgcn_mov_dpp(__builtin_bit_cast(int, v), 0x121, 0xf, 0xf, true)); }
__device__ __forceinline__ float dpp_ror2(float v) { return __builtin_bit_cast(float, __builtin_amdgcn_mov_dpp(__builtin_bit_cast(int, v), 0x122, 0xf, 0xf, true)); }
__device__ __forceinline__ float silu_f(float a) { return a * __builtin_amdgcn_rcpf(1.0f + __expf(-a)); }
struct EpiFfn {
    static constexpr bool PERM = true, AFTER_DRAIN = false;
    bf16_t* ACT; const PG8_LAS float* rtab; const float* cw; const float* cb; float* SG; float* SU; PG8_LAS float* xch;
    static constexpr int DFF_ = 2816;
    PG8_LAS float* cwl;
    __device__ __forceinline__ void prefetch(const Unit& u, int wid, int lane) const {
        const int wc = wid & 3;
#pragma unroll
        for (int j = 0; j < 2; ++j) { const int e = j * 64 + lane, k = e >> 5, c = e & 31; const float* src = (k < 3 ? cw + k * DFF_ : cb) + u.pn * 128 + wc * 32 + c;
            __builtin_amdgcn_global_load_lds((const unsigned*)src, (PG8_LAS unsigned*)(cwl + wid * 128 + j * 64), 4, 0, 0); }
    }
    __device__ __forceinline__ void operator()(const f32x4 (&acc)[2][2][4][2], const Unit& u, int wr, int wc, int fr_, int fq_) const {
        int fr = fr_, fq = fq_; asm volatile("" : "+v"(fr), "+v"(fq));
        const int row0 = u.pm * BM + wr * 64 + fr, ch0 = u.pn * 128 + wc * 32 + 8 * fq;
        float ri[2][4];
#pragma unroll
        for (int ai = 0; ai < 2; ++ai)
#pragma unroll
            for (int m = 0; m < 4; ++m) ri[ai][m] = rtab[((u.pm >> 3) & 1) * 256 + ai * HALF + wr * 64 + m * 16 + fr];
        f32x2 w0[4], w1[4], w2[4], bb[4];
        { const PG8_LAS float* my = cwl + (wr * 4 + wc) * 128 + 8 * fq; const float nl2e = -1.4426950408889634f;
          const f32x4 a0 = *(const PG8_LAS f32x4*)(my), a1 = *(const PG8_LAS f32x4*)(my + 4), b0 = *(const PG8_LAS f32x4*)(my + 32), b1 = *(const PG8_LAS f32x4*)(my + 36);
          const f32x4 c0 = *(const PG8_LAS f32x4*)(my + 64), c1 = *(const PG8_LAS f32x4*)(my + 68), d0 = *(const PG8_LAS f32x4*)(my + 96), d1 = *(const PG8_LAS f32x4*)(my + 100);
          w0[0] = (f32x2){a0[0], a0[1]} * nl2e; w0[1] = (f32x2){a0[2], a0[3]} * nl2e; w0[2] = (f32x2){a1[0], a1[1]} * nl2e; w0[3] = (f32x2){a1[2], a1[3]} * nl2e;
          w1[0] = (f32x2){b0[0], b0[1]} * nl2e; w1[1] = (f32x2){b0[2], b0[3]} * nl2e; w1[2] = (f32x2){b1[0], b1[1]} * nl2e; w1[3] = (f32x2){b1[2], b1[3]} * nl2e;
          w2[0] = (f32x2){c0[0], c0[1]} * nl2e; w2[1] = (f32x2){c0[2], c0[3]} * nl2e; w2[2] = (f32x2){c1[0], c1[1]} * nl2e; w2[3] = (f32x2){c1[2], c1[3]} * nl2e;
          bb[0] = (f32x2){d0[0], d0[1]} * nl2e; bb[1] = (f32x2){d0[2], d0[3]} * nl2e; bb[2] = (f32x2){d1[0], d1[1]} * nl2e; bb[3] = (f32x2){d1[2], d1[3]} * nl2e; }
        if (fr >= 14) {
#pragma unroll
            for (int ai = 0; ai < 2; ++ai) { PG8_LAS f32x4* x = (PG8_LAS f32x4*)(xch + ((((ai * 2 + wr) * 4 + wc) * 2 + (fr - 14)) * 64 + 8 * fq));
                x[0] = acc[ai][0][3][0] * ri[ai][3]; x[1] = acc[ai][0][3][1] * ri[ai][3]; }
        }
        EPI_LDS_BARRIER();
        const bool f0 = fr == 0, f01 = fr < 2;
#pragma unroll
        for (int ai = 0; ai < 2; ++ai) {
            const int pa = wr ? ai : ai - 1, pw = wr ? 0 : 1; f32x2 P1[4], P2[4];
#pragma unroll
            for (int e = 0; e < 4; ++e) { P1[e] = (f32x2){0.f, 0.f}; P2[e] = (f32x2){0.f, 0.f}; }
            if (fr < 2 && (ai | wr)) { const PG8_LAS f32x4* x1 = (const PG8_LAS f32x4*)(xch + ((((pa * 2 + pw) * 4 + wc) * 2 + 1) * 64 + 8 * fq));
                const PG8_LAS f32x4* x2 = (const PG8_LAS f32x4*)(xch + ((((pa * 2 + pw) * 4 + wc) * 2 + fr) * 64 + 8 * fq));
                const f32x4 a = x1[0], b = x1[1], c = x2[0], d = x2[1];
                P1[0] = (f32x2){a[0], a[1]}; P1[1] = (f32x2){a[2], a[3]}; P1[2] = (f32x2){b[0], b[1]}; P1[3] = (f32x2){b[2], b[3]};
                P2[0] = (f32x2){c[0], c[1]}; P2[1] = (f32x2){c[2], c[3]}; P2[2] = (f32x2){d[0], d[1]}; P2[3] = (f32x2){d[2], d[3]}; }
#if defined(PROBE_FFN_SYNCONLY)
            if (u.pass) { asm volatile("" :: "v"(P1[0]), "v"(P1[1]), "v"(P1[2]), "v"(P1[3]), "v"(P2[0]), "v"(P2[1]), "v"(P2[2]), "v"(P2[3]), "v"(w0[0]), "v"(w1[1]), "v"(w2[2]), "v"(bb[3]), "v"(ri[ai][0])); continue; }
#endif
#pragma unroll
            for (int m = 0; m < 4; ++m) { const int row = row0 + ai * HALF + m * 16; const float r = ri[ai][m], ru = r * -0.6931471805599453f;
                f32x2 G[4], U[4]; float y[8];
                G[0] = (f32x2){acc[ai][0][m][0][0], acc[ai][0][m][0][1]} * r; G[1] = (f32x2){acc[ai][0][m][0][2], acc[ai][0][m][0][3]} * r;
                G[2] = (f32x2){acc[ai][0][m][1][0], acc[ai][0][m][1][1]} * r; G[3] = (f32x2){acc[ai][0][m][1][2], acc[ai][0][m][1][3]} * r;
                U[0] = (f32x2){acc[ai][1][m][0][0], acc[ai][1][m][0][1]} * ru; U[1] = (f32x2){acc[ai][1][m][0][2], acc[ai][1][m][0][3]} * ru;
                U[2] = (f32x2){acc[ai][1][m][1][0], acc[ai][1][m][1][1]} * ru; U[3] = (f32x2){acc[ai][1][m][1][2], acc[ai][1][m][1][3]} * ru;
#pragma unroll
                for (int e = 0; e < 4; ++e) { f32x2 r1, r2, p1, p2; r1.x = dpp_ror1(G[e].x); r1.y = dpp_ror1(G[e].y); r2.x = dpp_ror2(G[e].x); r2.y = dpp_ror2(G[e].y);
                    p1.x = f0 ? P1[e].x : r1.x; p1.y = f0 ? P1[e].y : r1.y; p2.x = f01 ? P2[e].x : r2.x; p2.y = f01 ? P2[e].y : r2.y; P1[e] = r1; P2[e] = r2;
                    const f32x2 t = __builtin_elementwise_fma(w2[e], G[e], __builtin_elementwise_fma(w1[e], p1, __builtin_elementwise_fma(w0[e], p2, bb[e])));
                    f32x2 d; d.x = __builtin_amdgcn_rcpf(1.0f + __builtin_amdgcn_exp2f(t.x)); d.y = __builtin_amdgcn_rcpf(1.0f + __builtin_amdgcn_exp2f(t.y));
                    const f32x2 o = (t * U[e]) * d; y[2 * e] = o.x; y[2 * e + 1] = o.y; }
                const f32x4 Gs0 = (f32x4){G[0].x, G[0].y, G[1].x, G[1].y}, Gs1 = (f32x4){G[2].x, G[2].y, G[3].x, G[3].y};
                const bool tile_head = (ai == 0 && wr == 0 && m == 0 && fr < 2);
                if (!tile_head) { u32x4 w; w.x = cvt_pk_bf16(y[0], y[1]); w.y = cvt_pk_bf16(y[2], y[3]); w.z = cvt_pk_bf16(y[4], y[5]); w.w = cvt_pk_bf16(y[6], y[7]);
#if defined(PROBE_FFN_NOSTORE)
                    if (u.pass) asm volatile("" :: "v"(w.x), "v"(w.y), "v"(w.z), "v"(w.w)); else
#endif
                    *(u32x4*)(ACT + (size_t)row * DFF_ + ch0) = w; }
                else { float* sg = SG + ((size_t)u.pm * 4 + fr) * DFF_ + ch0; float* su = SU + ((size_t)u.pm * 2 + fr) * DFF_ + ch0; const float k = -1.4426950408889634f;
                    *(f32x4*)sg = Gs0; *(f32x4*)(sg + 4) = Gs1;
                    *(f32x4*)su = (f32x4){U[0].x, U[0].y, U[1].x, U[1].y} * k; *(f32x4*)(su + 4) = (f32x4){U[2].x, U[2].y, U[3].x, U[3].y} * k; }
                if (ai == 1 && wr == 1 && m == 3 && fr >= 14) { float* sg = SG + ((size_t)u.pm * 4 + 2 + (fr - 14)) * DFF_ + ch0; *(f32x4*)sg = Gs0; *(f32x4*)(sg + 4) = Gs1; }
                asm volatile("" ::: "memory"); }
        }
    }
};

template <int CTRL> __device__ __forceinline__ float dpp_ror(float v) { return __builtin_bit_cast(float, __builtin_amdgcn_mov_dpp(__builtin_bit_cast(int, v), CTRL, 0xf, 0xf, true)); }
struct EpiMix {
    static constexpr bool PERM = true, AFTER_DRAIN = false;
    typedef unsigned u32x2 __attribute__((ext_vector_type(2)));
    bf16_t* MIXO; float* SZ; const PG8_LAS float* rtab; const PG8_LAS float* cal; float* SAB; float* SCV; PG8_LAS float* xch;
    __device__ __forceinline__ void prefetch(const Unit&, int, int) const {}
    __device__ __forceinline__ void operator()(const f32x4 (&acc)[2][2][4][2], const Unit& u, int wr, int wc, int fr_, int fq_) const {
        int fr = fr_, fq = fq_; asm volatile("" : "+v"(fr), "+v"(fq));
        const int row0 = u.pm * BM + wr * 64 + fr, ch0 = u.pn * 64 + wc * 16 + 4 * fq;
        const int lw = (u.pn >> 1) + 1; const float rcw = lw == 1 ? 0.5f : lw == 2 ? 0.25f : lw == 3 ? 0.125f : 0.0625f;
        PG8_LAS u32x2* const zh = (PG8_LAS u32x2*)(xch + 512);
        float ri[2][4];
#pragma unroll
        for (int ai = 0; ai < 2; ++ai)
#pragma unroll
            for (int m = 0; m < 4; ++m) ri[ai][m] = rtab[((u.pm >> 3) & 1) * 256 + ai * HALF + wr * 64 + m * 16 + fr];
        const f32x4 w0 = *(const PG8_LAS f32x4*)(cal + ch0), w1 = *(const PG8_LAS f32x4*)(cal + 512 + ch0), w2 = *(const PG8_LAS f32x4*)(cal + 1024 + ch0);
        if (fr >= 14) {
#pragma unroll
            for (int ai = 0; ai < 2; ++ai) { const float r = ri[ai][3];
                *(PG8_LAS f32x4*)(xch + ((((ai * 2 + wr) * 4 + wc) * 2 + (fr - 14)) * 16 + 4 * fq)) = (acc[ai][0][3][1] * r) * (acc[ai][1][3][0] * r); } }
#pragma unroll
        for (int ai = 0; ai < 2; ++ai) { const f32x4 z = acc[ai][1][3][1] * ri[ai][3]; u32x2 w; w.x = cvt_pk_bf16(z[0], z[1]); w.y = cvt_pk_bf16(z[2], z[3]);
            zh[(((ai * 2 + wr) * 4 + wc) * 16 + fr) * 4 + fq] = w; }
        EPI_LDS_BARRIER();
        const bool f0 = fr == 0, f01 = fr < 2, f03 = fr < 4, f07 = fr < 8;
#pragma unroll
        for (int ai = 0; ai < 2; ++ai) {
            const int pa = wr ? ai : ai - 1, pw = wr ? 0 : 1; f32x4 P1 = {0.f, 0.f, 0.f, 0.f}, P2 = {0.f, 0.f, 0.f, 0.f};
            f32x4 R0 = {0.f, 0.f, 0.f, 0.f}, R1 = R0, R2 = R0, R4 = R0;
            if (fr < 2 && (ai | wr)) { P1 = *(const PG8_LAS f32x4*)(xch + ((((pa * 2 + pw) * 4 + wc) * 2 + 1) * 16 + 4 * fq)); P2 = *(const PG8_LAS f32x4*)(xch + ((((pa * 2 + pw) * 4 + wc) * 2 + fr) * 16 + 4 * fq)); }
            if (ai | wr) { const u32x2 hz = zh[(((pa * 2 + pw) * 4 + wc) * 16 + fr) * 4 + fq];
                f32x4 zp; zp[0] = __builtin_bit_cast(float, hz.x << 16); zp[1] = __builtin_bit_cast(float, hz.x & 0xffff0000u); zp[2] = __builtin_bit_cast(float, hz.y << 16); zp[3] = __builtin_bit_cast(float, hz.y & 0xffff0000u);
#pragma unroll
                for (int e = 0; e < 4; ++e) { const float r0 = dpp_ror<0x121>(zp[e]), s1 = zp[e] + r0, r1 = dpp_ror<0x122>(s1), s2 = s1 + r1, r2 = dpp_ror<0x124>(s2), s4 = s2 + r2;
                    R0[e] = r0; R1[e] = r1; R2[e] = r2; R4[e] = dpp_ror<0x128>(s4); } }
#pragma unroll
            for (int m = 0; m < 4; ++m) { const int row = row0 + ai * HALF + m * 16; const float r = ri[ai][m];
                const f32x4 ab = acc[ai][0][m][0] * r, cv = (acc[ai][0][m][1] * r) * (acc[ai][1][m][0] * r), z = acc[ai][1][m][1] * r; f32x4 y, pz;
#pragma unroll
                for (int e = 0; e < 4; ++e) { const float r1 = dpp_ror1(cv[e]), r2 = dpp_ror2(cv[e]); const float p1 = f0 ? P1[e] : r1, p2 = f01 ? P2[e] : r2; P1[e] = r1; P2[e] = r2;
                    y[e] = ab[e] * __builtin_fmaf(w2[e], cv[e], __builtin_fmaf(w1[e], p1, w0[e] * p2)); }
#pragma unroll
                for (int e = 0; e < 4; ++e) { float S; const float t0 = dpp_ror<0x121>(z[e]), s1 = z[e] + (f0 ? R0[e] : t0); R0[e] = t0; S = s1;
                    if (lw >= 2) { const float t1 = dpp_ror<0x122>(s1), s2 = s1 + (f01 ? R1[e] : t1); R1[e] = t1; S = s2;
                        if (lw >= 3) { const float t2 = dpp_ror<0x124>(s2), s4 = s2 + (f03 ? R2[e] : t2); R2[e] = t2; S = s4;
                            if (lw >= 4) { const float t4 = dpp_ror<0x128>(s4); S = s4 + (f07 ? R4[e] : t4); R4[e] = t4; } } }
                    pz[e] = __builtin_fmaf(S, rcw, -z[e]); }
                const bool head_blk = (ai == 0 && wr == 0 && m == 0);
                if (!(head_blk && fr < 15)) { u32x2 w; w.x = cvt_pk_bf16(pz[0], pz[1]); w.y = cvt_pk_bf16(pz[2], pz[3]); *(u32x2*)(MIXO + (size_t)row * 1024 + 512 + ch0) = w; }
                else *(f32x4*)(SZ + ((size_t)u.pm * 30 + fr) * 512 + ch0) = z;
                if (ai == 1 && wr == 1 && m == 3 && fr >= 1) *(f32x4*)(SZ + ((size_t)u.pm * 30 + 14 + fr) * 512 + ch0) = z;
                const bool tile_head = (head_blk && fr < 2);
                if (!tile_head) { u32x2 w; w.x = cvt_pk_bf16(y[0], y[1]); w.y = cvt_pk_bf16(y[2], y[3]); *(u32x2*)(MIXO + (size_t)row * 1024 + ch0) = w; }
                else { *(f32x4*)(SAB + ((size_t)u.pm * 2 + fr) * 512 + ch0) = ab; *(f32x4*)(SCV + ((size_t)u.pm * 4 + fr) * 512 + ch0) = cv; }
                if (ai == 1 && wr == 1 && m == 3 && fr >= 14) *(f32x4*)(SCV + ((size_t)u.pm * 4 + 2 + (fr - 14)) * 512 + ch0) = cv;
            }
        }
    }
};

template <class Epi, class Sched, bool ALIGN_EPI = false, bool SP2 = false>
__device__ __forceinline__ void gemm_phase(PG8_LAS unsigned char* lds, const Gemm g, const Sched& S, const Epi& E) {
    const int tid = threadIdx.x, wid = __builtin_amdgcn_readfirstlane(tid >> 6), lane = tid & 63, wr = wid >> 2, wc = wid & 3, fr = lane & 15, fq = lane >> 4;
    const int K = g.K, nt = K / BK;
    unsigned voffA[2], voffB[2];
#pragma unroll
    for (int i = 0; i < 2; ++i) { int R, C; stage_rc(tid * 16 + i * 8192, R, C); const int Rb = Epi::PERM ? ((R & ~31) + perm32(R & 31)) : R;
        voffA[i] = (unsigned)(R * K + C) * 2u; voffB[i] = (unsigned)(Rb * K + C) * 2u; }
    const size_t kstep = (size_t)(BK * 2);
    const size_t hstep = (size_t)HALF * K * 2;
    const size_t tstep = 2 * hstep;
    const unsigned ldsw = (unsigned)wid * 1024u;
    const int aoff = lds_byte(wr * 64 + fr, fq * 8), boff = lds_byte(wc * 32 + fr, fq * 8);
#define PG8_SA(b, h) (((b) * 2 + (h)) * HTB)
#define PG8_SB(b, h) ((4 + (b) * 2 + (h)) * HTB)
#ifndef PG8_SERPENTINE
#define PG8_SERPENTINE 1
#endif
#ifndef PG8_B_AUX
#define PG8_B_AUX 0
#endif
#define PG8_STAGE(bufoff, gbase, voff) do { _Pragma("unroll") for (int _i = 0; _i < 2; ++_i) \
        __builtin_amdgcn_global_load_lds((const unsigned*)((const char*)(gbase) + (voff)[_i]), (PG8_LAS unsigned*)(lds + (bufoff) + ldsw + _i * 8192), 16, 0, 0); } while (0)
#define PG8_STAGEB(bufoff, gbase, voff) do { _Pragma("unroll") for (int _i = 0; _i < 2; ++_i) \
        __builtin_amdgcn_global_load_lds((const unsigned*)((const char*)(gbase) + (voff)[_i]), (PG8_LAS unsigned*)(lds + (bufoff) + ldsw + _i * 8192), 16, 0, PG8_B_AUX); } while (0)
#define PG8_LDA(dst, b, h) do { _Pragma("unroll") for (int m = 0; m < 4; ++m) _Pragma("unroll") for (int k = 0; k < 2; ++k) dst[m][k] = *(const PG8_LAS bf16x8*)(lds + PG8_SA(b, h) + aoff + m * 2048 + k * 1024); } while (0)
#define PG8_LDB(dst, b, h) do { _Pragma("unroll") for (int n = 0; n < 2; ++n) _Pragma("unroll") for (int k = 0; k < 2; ++k) dst[n][k] = *(const PG8_LAS bf16x8*)(lds + PG8_SB(b, h) + boff + n * 2048 + k * 1024); } while (0)
#define PG8_MMA(ai, bj, At, Bt) do { __builtin_amdgcn_s_setprio(1); _Pragma("unroll") for (int m = 0; m < 4; ++m) _Pragma("unroll") for (int n = 0; n < 2; ++n) _Pragma("unroll") for (int k = 0; k < 2; ++k) \
        acc[ai][bj][m][n] = __builtin_amdgcn_mfma_f32_16x16x32_bf16(Bt[n][k], At[m][k], acc[ai][bj][m][n], 0, 0, 0); __builtin_amdgcn_s_setprio(0); } while (0)
#define PG8_WAIT_V(n) asm volatile("s_waitcnt vmcnt(" #n ")" ::: "memory")
#define PG8_WAIT_L(n) asm volatile("s_waitcnt lgkmcnt(" #n ")" ::: "memory")
#define PG8_BAR __builtin_amdgcn_s_barrier()
#define PG8_SCHED __builtin_amdgcn_sched_barrier(0)
    Unit cur, nxt; int ui = 0;
    if (!S.next(0, cur)) return;
    f32x4 acc[2][2][4][2];
#pragma unroll
    for (int a = 0; a < 2; ++a)
#pragma unroll
        for (int b = 0; b < 2; ++b)
#pragma unroll
            for (int m = 0; m < 4; ++m)
#pragma unroll
                for (int n = 0; n < 2; ++n) acc[a][b][m][n] = (f32x4){0.f, 0.f, 0.f, 0.f};
    bf16x8 At[4][2], B0[2][2], B1[2][2];
    const char* cA = (const char*)g.A + (size_t)cur.pm * tstep; const char* cB = (const char*)g.Bt + (size_t)cur.pn * tstep;
    S.a_ready(cur);
    if constexpr (SP2) {
        PG8_STAGEB(PG8_SB(0, 0), cB, voffB); PG8_STAGEB(PG8_SB(0, 1), cB + hstep, voffB); PG8_STAGE(PG8_SA(0, 0), cA, voffA); PG8_STAGE(PG8_SA(0, 1), cA + hstep, voffA);
        if (wr == 1) PG8_BAR;
        PG8_WAIT_V(2); PG8_BAR;
        PG8_STAGEB(PG8_SB(1, 0), cB + kstep, voffB); PG8_STAGE(PG8_SA(1, 0), cA + kstep, voffA); PG8_STAGEB(PG8_SB(1, 1), cB + hstep + kstep, voffB);
        PG8_WAIT_V(6); PG8_BAR;
    } else {
        PG8_STAGEB(PG8_SB(0, 0), cB, voffB); PG8_STAGE(PG8_SA(0, 0), cA, voffA); PG8_STAGEB(PG8_SB(0, 1), cB + hstep, voffB); PG8_STAGE(PG8_SA(0, 1), cA + hstep, voffA);
        if (wr == 1) PG8_BAR;
        PG8_WAIT_V(4); PG8_BAR;
        PG8_STAGEB(PG8_SB(1, 0), cB + kstep, voffB); PG8_STAGE(PG8_SA(1, 0), cA + kstep, voffA); PG8_STAGEB(PG8_SB(1, 1), cB + hstep + kstep, voffB);
        PG8_WAIT_V(6); PG8_BAR;
    }
    long ksc = (long)kstep;
    for (;;) {
        const bool has_next = S.next(ui + 1, nxt);
        const long ksn = has_next ? (((ui + 1) & 1) && PG8_SERPENTINE ? -(long)kstep : (long)kstep) : ksc; const size_t nk0 = (ksn < 0) ? (size_t)(nt - 1) * kstep : 0;
        const char* nA = has_next ? (const char*)g.A + (size_t)nxt.pm * tstep + nk0 : cA; const char* nB = has_next ? (const char*)g.Bt + (size_t)nxt.pn * tstep + nk0 : cB;
        for (int t = 0; t < nt; t += 2) {
            const bool last = (t == nt - 2);
            const char* a1 = cA + (long)(t + 1) * ksc;
            const char* a2 = last ? nA : cA + (long)(t + 2) * ksc; const char* b2 = last ? nB : cB + (long)(t + 2) * ksc;
            const long ks3 = last ? ksn : ksc; const char* a3 = a2 + ks3; const char* b3 = b2 + ks3;
            if (last && has_next) S.a_ready(nxt);
            if (last) E.prefetch(cur, wid, lane);
            if constexpr (SP2) {
            PG8_LDB(B0, 0, 0); PG8_LDB(B1, 0, 1); PG8_SCHED; PG8_LDA(At, 0, 0); PG8_STAGE(PG8_SA(1, 1), a1 + hstep, voffA);
            PG8_WAIT_V(8); PG8_WAIT_L(0); PG8_BAR; PG8_MMA(0, 0, At, B0); PG8_MMA(0, 1, At, B1); PG8_BAR; PG8_SCHED;
            PG8_LDA(At, 0, 1); PG8_STAGEB(PG8_SB(0, 0), b2, voffB); PG8_STAGEB(PG8_SB(0, 1), b2 + hstep, voffB); PG8_STAGE(PG8_SA(0, 0), a2, voffA);
            PG8_WAIT_V(8); PG8_WAIT_L(0); PG8_BAR; PG8_MMA(1, 0, At, B0); PG8_MMA(1, 1, At, B1); PG8_BAR; PG8_SCHED;
            PG8_LDB(B0, 1, 0); PG8_LDB(B1, 1, 1); PG8_SCHED; PG8_LDA(At, 1, 0); PG8_STAGE(PG8_SA(0, 1), a2 + hstep, voffA);
            PG8_WAIT_V(8); PG8_WAIT_L(0); PG8_BAR; PG8_MMA(0, 0, At, B0); PG8_MMA(0, 1, At, B1); PG8_BAR; PG8_SCHED;
            PG8_LDA(At, 1, 1); PG8_STAGEB(PG8_SB(1, 0), b3, voffB); PG8_STAGEB(PG8_SB(1, 1), b3 + hstep, voffB); PG8_STAGE(PG8_SA(1, 0), a3, voffA);
            PG8_WAIT_V(8); PG8_WAIT_L(0); PG8_BAR; PG8_MMA(1, 0, At, B0); PG8_MMA(1, 1, At, B1); PG8_BAR; PG8_SCHED;
            } else {
            PG8_LDB(B0, 0, 0); PG8_SCHED; PG8_LDA(At, 0, 0); PG8_STAGE(PG8_SA(1, 1), a1 + hstep, voffA);
            PG8_WAIT_L(8); PG8_BAR; PG8_WAIT_L(0); PG8_MMA(0, 0, At, B0); PG8_BAR; PG8_SCHED;
            PG8_LDB(B1, 0, 1); PG8_STAGEB(PG8_SB(0, 0), b2, voffB);
            PG8_BAR; PG8_WAIT_L(0); PG8_MMA(0, 1, At, B1); PG8_BAR;
            PG8_LDA(At, 0, 1); PG8_STAGE(PG8_SA(0, 0), a2, voffA);
            PG8_BAR; PG8_WAIT_L(0); PG8_MMA(1, 0, At, B0); PG8_BAR; PG8_SCHED;
            PG8_STAGEB(PG8_SB(0, 1), b2 + hstep, voffB);
            PG8_WAIT_V(6); PG8_BAR; PG8_MMA(1, 1, At, B1); PG8_BAR;
            PG8_LDB(B0, 1, 0); PG8_SCHED; PG8_LDA(At, 1, 0); PG8_STAGE(PG8_SA(0, 1), a2 + hstep, voffA);
            PG8_WAIT_L(8); PG8_BAR; PG8_WAIT_L(0); PG8_MMA(0, 0, At, B0); PG8_BAR; PG8_SCHED;
            PG8_LDB(B1, 1, 1); PG8_STAGEB(PG8_SB(1, 0), b3, voffB);
            PG8_BAR; PG8_WAIT_L(0); PG8_MMA(0, 1, At, B1); PG8_BAR;
            PG8_LDA(At, 1, 1); PG8_STAGE(PG8_SA(1, 0), a3, voffA);
            PG8_BAR; PG8_WAIT_L(0); PG8_MMA(1, 0, At, B0); PG8_BAR; PG8_SCHED;
            PG8_STAGEB(PG8_SB(1, 1), b3 + hstep, voffB);
            PG8_WAIT_V(6); PG8_BAR; PG8_MMA(1, 1, At, B1); PG8_BAR;
            }
        }
#if PG8_PROBE_EPI
        unsigned te0_ = 0u; if (wid == 0) te0_ = (unsigned)__builtin_amdgcn_s_memrealtime();
#endif
        if constexpr (ALIGN_EPI) { if (wr == 0) PG8_BAR; }
        if constexpr (!Epi::AFTER_DRAIN) { if (S.live(ui)) E(acc, cur, wr, wc, fr, fq); S.done(cur); }
#if PG8_PROBE_EPI
        if (wid == 0 && lane == 0) { volatile PG8_LAS unsigned* pm_ = (volatile PG8_LAS unsigned*)(lds + 131072 + 320); if (pm_[15]) pm_[14] += (unsigned)__builtin_amdgcn_s_memrealtime() - te0_; }
#endif
        if (!has_next) break;
#pragma unroll
        for (int a = 0; a < 2; ++a)
#pragma unroll
            for (int b = 0; b < 2; ++b)
#pragma unroll
                for (int m = 0; m < 4; ++m)
#pragma unroll
                    for (int n = 0; n < 2; ++n) acc[a][b][m][n] = (f32x4){0.f, 0.f, 0.f, 0.f};
        cur = nxt; cA = nA; cB = nB; ksc = ksn; ++ui;
        if constexpr (ALIGN_EPI) { if (wr == 1) PG8_BAR; }
    }
    PG8_WAIT_V(0);
    if constexpr (!ALIGN_EPI) { if (wr == 0) PG8_BAR; }
    PG8_BAR;
    if constexpr (Epi::AFTER_DRAIN) { E.fused(acc, cur, wr, wc, fr, fq, lds, wid, lane); S.done(cur); }
#undef PG8_SA
#undef PG8_SB
#undef PG8_STAGE
#undef PG8_STAGEB
#undef PG8_LDA
#undef PG8_LDB
#undef PG8_MMA
#undef PG8_WAIT_V
#undef PG8_WAIT_L
#undef PG8_BAR
#undef PG8_SCHED
}
}

constexpr int NWAVES = 8;
#ifndef MK_PER_PHASE
#define MK_PER_PHASE 0
#endif
constexpr int NPHASE = 14;
#ifndef NOEPI_MASK
#define NOEPI_MASK 0
#endif
#ifndef LOCAL_BARRIERS
#define LOCAL_BARRIERS 1
#endif
#ifndef PROBE_REP
#define PROBE_REP 1
#endif
#ifndef NOEPI_MODE
#define NOEPI_MODE 1
#endif
#ifndef PROBE_STAMP
#define PROBE_STAMP 0
#endif
#ifndef PROBE_SCALE
#define PROBE_SCALE 1.0f
#endif
#ifndef PROBE_OFF
#define PROBE_OFF 0.0f
#endif
#ifndef PROBE_FILTER
#define PROBE_FILTER 0
#endif
#ifndef DBL_MASK
#define DBL_MASK 0
#endif

constexpr int BATCH = 8, SEQ = 4096, D = 1024, M = BATCH * SEQ;
constexpr int AW = 512, EVEN_IN = 2048, DFF = 2816, NGU = 2 * DFF;
constexpr int RUN = 32;

constexpr size_t MiB = 1u << 20;
constexpr size_t WS_CTL = 0, CTL_ZERO_BYTES = 72 * 1024;
constexpr size_t WS_WIN0 = 1 * MiB, WS_WOUT0 = 5 * MiB, WS_WIN1 = 7 * MiB, WS_WOUT1 = 11 * MiB, WS_WGU0 = 13 * MiB, WS_WGU1 = 24 * MiB;
constexpr size_t WS_WD0 = 35 * MiB, WS_WD1 = WS_WD0 + (size_t)D * DFF * 2, WS_PART = 46 * MiB;
constexpr size_t PART_BYTES = (size_t)M * 16 * 4;
constexpr size_t WS_SG = 56 * MiB, WS_SU = WS_SG + (size_t)128 * 4 * DFF * 4;
constexpr size_t WS_SAB = WS_SU + (size_t)128 * 2 * DFF * 4, WS_SCV = WS_SAB + (size_t)128 * 2 * 512 * 4;
constexpr size_t WS_HB = 66 * MiB;
constexpr size_t WS_C = 130 * MiB;
constexpr size_t WS_ACT = WS_C, WS_PROJ = WS_C + 176 * MiB, WS_MIX = WS_C + 304 * MiB, WS_SZ = WS_C + 368 * MiB;
constexpr size_t WS_END = WS_C + 376 * MiB;
static_assert(WS_WD1 + (size_t)D * DFF * 2 <= WS_PART && WS_PART + 5 * PART_BYTES <= WS_SG && WS_SCV + (size_t)128 * 4 * 512 * 4 <= WS_HB && WS_HB + (size_t)M * D * 2 <= WS_C, "ws map");
static_assert((size_t)M * DFF * 2 == 176 * MiB && (size_t)M * EVEN_IN * 2 == 128 * MiB, "ws map sizes");
constexpr int CW_BAR = 4096, CW_CNT = 8192, CW_LOC = 16384;
constexpr int CW_DUMMY_ = 0;

constexpr int RING_OFF = 0, RING_BYTES = 131072;
constexpr int LDSCTL_OFF = RING_BYTES, MISC_OFF = LDSCTL_OFF + 320;
constexpr int LDS_BYTES = 156672;
constexpr int XCH_OFF = RING_BYTES + 1024, RED_OFF = XCH_OFF + 8192, RTAB_OFF = RED_OFF + 4096, CWL_OFF = RTAB_OFF + 2048, CAL_OFF = CWL_OFF + 4096;
static_assert(RING_OFF == 0 && MISC_OFF == 131072 + 320 && (CW_CNT + 128 * 64) * 4 <= (int)CTL_ZERO_BYTES && RED_OFF + 4096 == RTAB_OFF && MISC_OFF + 128 <= XCH_OFF && CAL_OFF + 6144 <= LDS_BYTES, "LDS map");

#define GAS __attribute__((address_space(1)))
#define LAS __attribute__((address_space(3)))
typedef unsigned short bf16;
typedef unsigned v4u __attribute__((ext_vector_type(4)));
typedef float f32x4 __attribute__((ext_vector_type(4)));
typedef short bf16x8 __attribute__((ext_vector_type(8)));
typedef GAS unsigned gu32;
typedef GAS unsigned long long gu64;
#define RLX_AGENT __ATOMIC_RELAXED, __HIP_MEMORY_SCOPE_AGENT
#define LDS_WAIT() asm volatile("s_waitcnt lgkmcnt(0)" ::: "memory")
#define VM_WAIT() asm volatile("s_waitcnt vmcnt(0)" ::: "memory")
__device__ __forceinline__ unsigned long long rt() { return __builtin_amdgcn_s_memrealtime(); }
__device__ __forceinline__ unsigned f2bf(float f) { unsigned u = __builtin_bit_cast(unsigned, f); return (u + 0x7fffu + ((u >> 16) & 1u)) >> 16; }
__device__ __forceinline__ unsigned pk2(float lo, float hi) { return f2bf(lo) | (f2bf(hi) << 16); }

#define XB_TMO      128
#define XB_XCNT(j)  (256  + 64 * (j))
#define XB_XSUB(j)  (1280 + 64 * (j))
#define XB_XGEN(j)  (2304 + 64 * (j))
#define XB_TOP      3328
#define XB_TOPGEN   3392
#define XCD_BAR_WORDS 3456
#define XB_SPIN_CAP (1u << 18)

__device__ __forceinline__ unsigned xb_ld(unsigned* p)              { return __hip_atomic_load(p, __ATOMIC_RELAXED, __HIP_MEMORY_SCOPE_AGENT); }
__device__ __forceinline__ unsigned xb_add(unsigned* p, unsigned v) { return __hip_atomic_fetch_add(p, v, __ATOMIC_RELAXED, __HIP_MEMORY_SCOPE_AGENT); }
__device__ __forceinline__ unsigned xb_xcc_id() { return (unsigned)__builtin_amdgcn_s_getreg((3 << 11) | 20) & 0xFu; }
#define XB_SPIN(cond, bar) do { unsigned _sp = 0; while (cond) { __builtin_amdgcn_s_sleep(1); \
    if ((++_sp & 255u) == 0u) { if (xb_ld(&(bar)[XB_TMO])) break; if (_sp > XB_SPIN_CAP) { atomicAdd(&(bar)[XB_TMO], 1u); break; } } } } while (0)

struct XcdBarrier {
    unsigned* bar; unsigned x;
    volatile LAS unsigned* st;
};

__device__ __forceinline__ XcdBarrier xcd_barrier_post(unsigned* bar, volatile LAS unsigned* st) {
    XcdBarrier b; b.bar = bar; b.x = xb_xcc_id(); b.st = st;
    if (threadIdx.x == 0) (void)xb_add(&bar[XB_XCNT(b.x)], 1u);
    return b;
}
__device__ __forceinline__ void xcd_barrier_complete(unsigned* bar, unsigned x, unsigned& nloc, unsigned& nx) {
    const unsigned G = gridDim.x * gridDim.y * gridDim.z;
    unsigned sum, cnt, mine, sp = 0u;
    for (;;) {
        sum = 0u; cnt = 0u; mine = 0u;
#pragma unroll
        for (unsigned j = 0; j < 16; ++j) { const unsigned c = xb_ld(&bar[XB_XCNT(j)]); sum += c; cnt += (c > 0u) ? 1u : 0u; mine = (j == x) ? c : mine; }
        if (sum == G) break;
        __builtin_amdgcn_s_sleep(1);
        if ((++sp & 255u) == 0u) { if (xb_ld(&bar[XB_TMO])) break; if (sp > XB_SPIN_CAP) { atomicAdd(&bar[XB_TMO], 1u); break; } }
    }
    nloc = mine > 0u ? mine : 1u; nx = cnt > 0u ? cnt : 1u;
}

__device__ __forceinline__ void xcd_barrier(const XcdBarrier& b) {
    asm volatile("s_waitcnt vmcnt(0)" ::: "memory");
    __syncthreads();
    if (threadIdx.x == 0) {
        unsigned* bar = b.bar;
        __builtin_amdgcn_s_waitcnt(0);
        unsigned nloc = b.st[0], nx = b.st[1];
        if (nloc == 0u) { xcd_barrier_complete(bar, b.x, nloc, nx); b.st[0] = nloc; b.st[1] = nx; }
        const unsigned old = xb_add(&bar[XB_XSUB(b.x)], 1u);
        const unsigned gen = old / nloc;
        if (old + 1u == (gen + 1u) * nloc) {
            __builtin_amdgcn_fence(__ATOMIC_RELEASE, "agent");
            asm volatile("s_waitcnt vmcnt(0)" ::: "memory");
            const unsigned og = xb_add(&bar[XB_TOP], 1u);
            const unsigned tg = og / nx;
            if (og + 1u == (tg + 1u) * nx) xb_add(&bar[XB_TOPGEN], 1u);
            else XB_SPIN(xb_ld(&bar[XB_TOPGEN]) == tg, bar);
            __builtin_amdgcn_fence(__ATOMIC_ACQUIRE, "agent");
            xb_add(&bar[XB_XGEN(b.x)], 1u);
            asm volatile("s_waitcnt vmcnt(0)" ::: "memory");
        } else {
            XB_SPIN(xb_ld(&bar[XB_XGEN(b.x)]) == gen, bar);
            __builtin_amdgcn_fence(__ATOMIC_ACQUIRE, "agent");
            asm volatile("s_waitcnt vmcnt(0)" ::: "memory");
        }
    }
    __syncthreads();
}


__device__ __forceinline__ void xcd_local_barrier(const XcdBarrier& b, unsigned* lw) {
    asm volatile("s_waitcnt vmcnt(0)" ::: "memory");
    __syncthreads();
    if (threadIdx.x == 0) {
        __builtin_amdgcn_s_waitcnt(0);
        const unsigned nloc = b.st[0];
        const unsigned old = xb_add(&lw[64u * b.x], 1u);
        const unsigned tgt = (old / nloc + 1u) * nloc;
        if (old + 1u != tgt) XB_SPIN(xb_ld(&lw[64u * b.x]) < tgt, b.bar);
        __builtin_amdgcn_fence(__ATOMIC_ACQUIRE, "agent");
        asm volatile("s_waitcnt vmcnt(0)" ::: "memory");
    }
    __syncthreads();
}

__device__ __forceinline__ float wave_sum(float v) {
#pragma unroll
    for (int o = 1; o < 64; o <<= 1) v += __shfl_xor(v, o);
    return v;
}
__device__ __forceinline__ float bf_lo(unsigned w) { return __builtin_bit_cast(float, w << 16); }
__device__ __forceinline__ float bf_hi(unsigned w) { return __builtin_bit_cast(float, w & 0xffff0000u); }
__device__ __forceinline__ void unpack8(const v4u w, float (&f)[8]) { f[0] = bf_lo(w.x); f[1] = bf_hi(w.x); f[2] = bf_lo(w.y); f[3] = bf_hi(w.y); f[4] = bf_lo(w.z); f[5] = bf_hi(w.z); f[6] = bf_lo(w.w); f[7] = bf_hi(w.w); }
__device__ __forceinline__ v4u pack8(const float (&f)[8]) { v4u w; w.x = pk2(f[0], f[1]); w.y = pk2(f[2], f[3]); w.z = pk2(f[4], f[5]); w.w = pk2(f[6], f[7]); return w; }

struct Frame {
    LAS unsigned char* lds;
    volatile LAS unsigned* MISC;
    gu32* ctl;
    int tid, lane, wave, vcu, G, xg, rk;
    const float* in[19]; float* out; unsigned char* ws;
};
#define PHASE_BEGIN(k) do { if ((PROBE_STAMP == 200 + (k) || PROBE_STAMP == 300 + (k)) && F.tid == 0) F.MISC[15] = 1u; } while (0)

__device__ __forceinline__ int mixmap(int nsrc) { const int kind = nsrc >> 9, ch = nsrc & 511; return 256 * (ch >> 6) + 128 * (kind >> 1) + 32 * ((ch >> 4) & 3) + 8 * ((ch >> 2) & 3) + 4 * (kind & 1) + (ch & 3); }
struct P0Desc { const float* W; const float* gain; bf16* WT; int ldw, ldt, roff, k0, n0, mm; };
__device__ __forceinline__ void p0_titem_load(const P0Desc& d, int lane, f32x4 (&v)[8], float (&gn)[8]) {
    const int r = lane >> 3, c4 = 4 * (lane & 7);
#pragma unroll
    for (int i = 0; i < 8; ++i) { v[i] = __builtin_nontemporal_load((const f32x4*)(d.W + (size_t)(d.k0 + r + 8 * i) * d.ldw + d.n0 + c4)); gn[i] = d.gain ? d.gain[d.k0 + r + 8 * i] : 1.0f; }
}
__device__ __forceinline__ void p0_titem_store(const P0Desc& d, LAS float* scr, int lane, const f32x4 (&v)[8], const float (&gn)[8]) {
    const int r = lane >> 3, c4 = 4 * (lane & 7);
#pragma unroll
    for (int i = 0; i < 8; ++i) { LAS float* q = scr + (r + 8 * i) * 33 + c4; q[0] = v[i].x * gn[i]; q[1] = v[i].y * gn[i]; q[2] = v[i].z * gn[i]; q[3] = v[i].w * gn[i]; }
    LDS_WAIT(); asm volatile("" ::: "memory");
    const int c = lane & 7;
#pragma unroll
    for (int j = 0; j < 4; ++j) { const int n = (lane >> 3) + 8 * j; const LAS float* t = scr + (8 * c) * 33 + n;
        v4u o; o.x = pk2(t[0 * 33], t[1 * 33]); o.y = pk2(t[2 * 33], t[3 * 33]); o.z = pk2(t[4 * 33], t[5 * 33]); o.w = pk2(t[6 * 33], t[7 * 33]);
        *(GAS v4u*)(d.WT + (size_t)(d.mm ? mixmap(d.n0 + n) : d.roff + d.n0 + n) * d.ldt + d.k0 + 8 * c) = o; }
    LDS_WAIT(); asm volatile("" ::: "memory");
}
__device__ __forceinline__ void p0_fold_item(const float* wpool, const float* scale, const float* Wo, bf16* WT, LAS float* scr, int item, int lane) {
    const int g = item >> 8, nb = (item >> 2) & 63, ib = item & 3, dq = lane >> 4, n = nb * 16 + (lane & 15), i0 = ib * 32;
    const float* wo = Wo + (size_t)(512 + g * 128 + dq * 32) * 1024 + n; const float* sc = scale + g * 128 + dq * 32; const float* wp = wpool + ((size_t)g * 128 + i0) * 128;
    float w0[4], w1[4], w2[4];
#pragma unroll
    for (int e = 0; e < 4; ++e) { w0[e] = wo[(size_t)e * 1024] * sc[e]; w1[e] = wo[(size_t)(4 + e) * 1024] * sc[4 + e]; w2[e] = wo[(size_t)(8 + e) * 1024] * sc[8 + e]; }
#pragma unroll
    for (int j = 0; j < 16; ++j) *(LAS f32x4*)(scr + 4 * (lane + 64 * j)) = *(const GAS f32x4*)(wp + 4 * (lane + 64 * j));
    LDS_WAIT(); asm volatile("" ::: "memory");
    float a[32];
#pragma unroll
    for (int i = 0; i < 32; ++i) a[i] = 0.f;
#pragma unroll 1
    for (int d4 = 0; d4 < 8; ++d4) { float w3[4]; const int dn = d4 + 3 < 8 ? d4 + 3 : 7;
#pragma unroll
        for (int e = 0; e < 4; ++e) w3[e] = wo[(size_t)(4 * dn + e) * 1024] * sc[4 * dn + e];
#pragma unroll
        for (int i = 0; i < 32; ++i) { const f32x4 p = *(const LAS f32x4*)(scr + i * 128 + dq * 32 + 4 * d4); a[i] += (p[0] * w0[0] + p[1] * w0[1]) + (p[2] * w0[2] + p[3] * w0[3]); }
#pragma unroll
        for (int e = 0; e < 4; ++e) { w0[e] = w1[e]; w1[e] = w2[e]; w2[e] = w3[e]; } }
#pragma unroll
    for (int i = 0; i < 32; ++i) { a[i] += __shfl_xor(a[i], 16); a[i] += __shfl_xor(a[i], 32); }
    if (dq == 0) {
#pragma unroll
        for (int q = 0; q < 4; ++q) { float t[8];
#pragma unroll
            for (int e = 0; e < 8; ++e) t[e] = a[8 * q + e];
            *(GAS v4u*)(WT + (size_t)n * 1024 + 512 + g * 128 + i0 + 8 * q) = pack8(t); } }
    LDS_WAIT(); asm volatile("" ::: "memory");
}
__device__ __forceinline__ void p0_prologue(Frame& F) {
    LAS float* scr = (LAS float*)(F.lds + RING_OFF + F.wave * 16384);
    const int gw = F.vcu * NWAVES + F.wave, NGW = F.G * NWAVES;
    bf16* Win0 = (bf16*)(F.ws + WS_WIN0); bf16* Wout0 = (bf16*)(F.ws + WS_WOUT0); bf16* Win1 = (bf16*)(F.ws + WS_WIN1); bf16* Wout1 = (bf16*)(F.ws + WS_WOUT1);
    bf16* Wgu0 = (bf16*)(F.ws + WS_WGU0); bf16* Wgu1 = (bf16*)(F.ws + WS_WGU1); bf16* Wd0 = (bf16*)(F.ws + WS_WD0); bf16* Wd1 = (bf16*)(F.ws + WS_WD1);
    constexpr int I_IN = 16 * 64, I_OA = 8 * 32, I_O1 = 16 * 32, I_GU = 16 * 88, I_D = 44 * 32, I_F = 1024;
    constexpr int NITEMS = 2 * I_IN + I_OA + I_O1 + 4 * I_GU + 2 * I_D + I_F;
    for (int it = gw - NGW / 2; it >= 0 && it < I_F; it += NGW) p0_fold_item(F.in[6], F.in[7], F.in[8], Wout0, scr, it, F.lane);
    const auto decode = [&](int r) { P0Desc d; d.roff = 0; d.mm = 0; d.gain = nullptr;
        if (r < I_IN) { d.W = F.in[4]; d.ldw = 2048; d.WT = Win0; d.ldt = 1024; d.gain = F.in[1]; d.mm = 1; d.k0 = 64 * (r / 64); d.n0 = 32 * (r % 64); return d; } r -= I_IN;
        if (r < I_IN) { d.W = F.in[9]; d.ldw = 2048; d.WT = Win1; d.ldt = 1024; d.gain = F.in[1] + 1024; d.k0 = 64 * (r / 64); d.n0 = 32 * (r % 64); return d; } r -= I_IN;
        if (r < I_OA) { d.W = F.in[8]; d.ldw = 1024; d.WT = Wout0; d.ldt = 1024; d.k0 = 64 * (r / 32); d.n0 = 32 * (r % 32); return d; } r -= I_OA;
        if (r < I_O1) { d.W = F.in[13]; d.ldw = 1024; d.WT = Wout1; d.ldt = 1024; d.k0 = 64 * (r / 32); d.n0 = 32 * (r % 32); return d; } r -= I_O1;
        if (r < 4 * I_GU) { const int w = r / I_GU, rr = r % I_GU, l = w >> 1, isup = w & 1;
            d.W = (isup ? F.in[15] : F.in[14]) + (size_t)l * 1024 * DFF; d.ldw = DFF; d.WT = l ? Wgu1 : Wgu0; d.ldt = 1024; d.gain = F.in[2] + l * 1024;
            d.roff = ((32 * (rr % 88)) / 128) * 256 + ((32 * (rr % 88)) % 128) + isup * 128 - 32 * (rr % 88); d.k0 = 64 * (rr / 88); d.n0 = 32 * (rr % 88); return d; } r -= 4 * I_GU;
        { const int l = r / I_D, rr = r % I_D; d.W = F.in[18] + (size_t)l * DFF * 1024; d.ldw = 1024; d.WT = l ? Wd1 : Wd0; d.ldt = DFF; d.k0 = 64 * (rr / 32); d.n0 = 32 * (rr % 32); return d; } };
    constexpr int NT = NITEMS - I_F;
    { int it = gw; f32x4 v[8], vn[8]; float gn[8], gnn[8]; P0Desc cur, nxt;
      if (it < NT) { cur = decode(it); p0_titem_load(cur, F.lane, v, gn); }
      while (it < NT) { const int itn = it + NGW; const bool more = itn < NT;
          if (more) { nxt = decode(itn); p0_titem_load(nxt, F.lane, vn, gnn); }
          p0_titem_store(cur, scr, F.lane, v, gn);
          if (more) { cur = nxt;
#pragma unroll
              for (int i = 0; i < 8; ++i) { v[i] = vn[i]; gn[i] = gnn[i]; } }
          it = itn; } }
    bf16* hb = (bf16*)(F.ws + WS_HB); float* part0 = (float*)(F.ws + WS_PART);
    { f32x4 v[4][4], vn[4][4]; const bool lowh = gw < NGW / 2; const int qstep = NGW / 2, qend = lowh ? (M / 4) * 4 / 8 : M / 4; int m0 = (lowh ? gw : (M / 4) * 4 / 8 + gw - NGW / 2) * 4;
      const auto ldrows = [&](int mm, f32x4 (&d)[4][4]) {
#pragma unroll
          for (int q = 0; q < 4; ++q) { const GAS f32x4* xr = (const GAS f32x4*)(F.in[0] + (size_t)(mm + q) * D) + F.lane;
#pragma unroll
              for (int j = 0; j < 4; ++j) d[q][j] = __builtin_nontemporal_load((const f32x4*)xr + 64 * j); } };
      if (m0 < qend * 4) ldrows(m0, v);
      while (m0 < qend * 4) { const int m1 = m0 + qstep * 4; const bool more = m1 < qend * 4; float sq[4];
          if (more) ldrows(m1, vn);
#pragma unroll
          for (int q = 0; q < 4; ++q) { float t = 0.f;
#pragma unroll
              for (int j = 0; j < 4; ++j) t += (v[q][j].x * v[q][j].x + v[q][j].y * v[q][j].y) + (v[q][j].z * v[q][j].z + v[q][j].w * v[q][j].w);
              sq[q] = wave_sum(t);
              GAS unsigned long long* o8 = (GAS unsigned long long*)(hb + (size_t)(m0 + q) * D) + F.lane;
#pragma unroll
              for (int j = 0; j < 4; ++j) o8[64 * j] = (unsigned long long)pk2(v[q][j].x, v[q][j].y) | ((unsigned long long)pk2(v[q][j].z, v[q][j].w) << 32); }
          if (F.lane < 16) part0[(size_t)m0 * 4 + F.lane] = (F.lane & 3) ? 0.f : (F.lane == 0 ? sq[0] : F.lane == 4 ? sq[1] : F.lane == 8 ? sq[2] : sq[3]);
          if (more) {
#pragma unroll
              for (int q = 0; q < 4; ++q)
#pragma unroll
                  for (int j = 0; j < 4; ++j) v[q][j] = vn[q][j]; }
          m0 = m1; } }
}

template <class Sched> __device__ __forceinline__ void mix_fixup_local(Frame& F, const Sched& S) {
    pg8::Unit ua, ub; S.next(0, ua); S.next(1, ub);
    bf16* mix = (bf16*)(F.ws + WS_MIX);
    const int pm = ((F.tid >> 7) & 1) ? ub.pm : ua.pm, t = F.tid & 127; const bool seq_start = (pm % (SEQ / 256)) == 0;
    if (F.tid < 256) {
        const float* SZ = (const float*)(F.ws + WS_SZ); const int ch = 4 * t, w = 2 << (t >> 5);
        f32x4 zz[30];
#pragma unroll
        for (int i = 0; i < 15; ++i) zz[i] = (f32x4){0.f, 0.f, 0.f, 0.f};
        if (!seq_start) {
#pragma unroll
            for (int i = 0; i < 15; ++i) zz[i] = *(const GAS f32x4*)(SZ + ((size_t)(pm - 1) * 30 + 15 + i) * 512 + ch); }
#pragma unroll
        for (int i = 0; i < 15; ++i) zz[15 + i] = *(const GAS f32x4*)(SZ + ((size_t)pm * 30 + i) * 512 + ch);
#pragma unroll
        for (int j = 0; j < 15; ++j) { f32x4 sx = {0.f, 0.f, 0.f, 0.f};
#pragma unroll
            for (int k = 0; k < 16; ++k) { const f32x4 a = zz[15 + j - k]; if (k < w) sx += a; }
            const float rc = 1.0f / (float)(seq_start ? min(j + 1, w) : w); const f32x4 y = sx * rc - zz[15 + j];
            *(GAS unsigned long long*)(mix + (size_t)(pm * 256 + j) * D + 512 + ch) = (unsigned long long)pk2(y[0], y[1]) | ((unsigned long long)pk2(y[2], y[3]) << 32); }
    } else {
        const float* SAB = (const float*)(F.ws + WS_SAB); const float* SCV = (const float*)(F.ws + WS_SCV); const float* ca = F.in[5];
        const int oc = t & 63, j = t >> 6, ch = 8 * oc;
        const float* own = SCV + ((size_t)pm * 4) * 512 + ch; const float* prv = SCV + ((size_t)(pm - 1) * 4) * 512 + ch; float y[8];
#pragma unroll
        for (int e = 0; e < 8; ++e) { float p2 = 0.f, p1 = 0.f, c0;
            if (j == 0) { if (!seq_start) { p2 = prv[2 * 512 + e]; p1 = prv[3 * 512 + e]; } c0 = own[e]; }
            else { if (!seq_start) p2 = prv[3 * 512 + e]; p1 = own[e]; c0 = own[512 + e]; }
            y[e] = SAB[((size_t)pm * 2 + j) * 512 + ch + e] * (ca[ch + e] * p2 + ca[512 + ch + e] * p1 + ca[1024 + ch + e] * c0); }
        *(GAS v4u*)(mix + (size_t)(pm * 256 + j) * D + ch) = pack8(y);
    }
    VM_WAIT(); __syncthreads();
}

template <class Sched> __device__ __forceinline__ void fixup_local(Frame& F, const Sched& S, int layer) {
    const float* SG = (const float*)(F.ws + WS_SG); const float* SU = (const float*)(F.ws + WS_SU); bf16* act = (bf16*)(F.ws + WS_ACT);
    const float* cw = F.in[16] + (size_t)layer * 3 * DFF; const float* cb = F.in[17] + (size_t)layer * DFF;
    constexpr int NOCT = DFF / 8; int done = 0;
    for (int i = 0; ; ++i) { pg8::Unit un; if (!S.next(i, un)) break; const int slot = (un.pm >> 3) & 1; if (done & (1 << slot)) continue; done |= 1 << slot;
        const int pm = un.pm; const bool seq_start = (pm % (SEQ / 256)) == 0;
        for (int it = F.tid; it < 2 * NOCT; it += NWAVES * 64) {
            const int o = it % NOCT, j = it / NOCT, ch = 8 * o;
            float p2[8], p1[8], g[8], u[8], y[8];
#pragma unroll
            for (int e = 0; e < 8; ++e) { p2[e] = 0.f; p1[e] = 0.f; }
            const float* own = SG + ((size_t)pm * 4) * DFF + ch; const float* prv = SG + ((size_t)(pm - 1) * 4) * DFF + ch;
            if (j == 0) { if (!seq_start) {
#pragma unroll
                    for (int e = 0; e < 8; ++e) { p2[e] = prv[2 * DFF + e]; p1[e] = prv[3 * DFF + e]; } }
#pragma unroll
                for (int e = 0; e < 8; ++e) g[e] = own[e]; }
            else { if (!seq_start) {
#pragma unroll
                    for (int e = 0; e < 8; ++e) p2[e] = prv[3 * DFF + e]; }
#pragma unroll
                for (int e = 0; e < 8; ++e) { p1[e] = own[e]; g[e] = own[DFF + e]; } }
#pragma unroll
            for (int e = 0; e < 8; ++e) { u[e] = SU[((size_t)pm * 2 + j) * DFF + ch + e];
                y[e] = pg8::silu_f(cw[ch + e] * p2[e] + cw[DFF + ch + e] * p1[e] + cw[2 * DFF + ch + e] * g[e] + cb[ch + e]) * u[e]; }
            *(GAS v4u*)(act + (size_t)(pm * 256 + j) * DFF + ch) = pack8(y);
        } }
    VM_WAIT(); __syncthreads();
}

constexpr int VT_PITCH = 136;
__device__ __forceinline__ void sgu_phase(Frame& F) {
    const bf16* proj = (const bf16*)(F.ws + WS_PROJ); bf16* mix = (bf16*)(F.ws + WS_MIX); const float* vpart = (const float*)(F.ws + WS_PART + 3 * PART_BYTES);
    LAS bf16* vT = (LAS bf16*)(F.lds + RING_OFF); LAS float* rvs = (LAS float*)(F.lds + RING_OFF + 128 * VT_PITCH * 2);
    const int h = F.rk & 7, fr = F.lane & 15, fq = F.lane >> 4, wv = F.wave, t = 16 * wv + fr, qstep = F.G >> 6, nq = (F.xg + 1) * (SEQ / 128);
    float wsr[4][8];
#pragma unroll
    for (int ks = 0; ks < 4; ++ks) { const float* wp = F.in[11] + ((size_t)h * 128 + t) * 128 + 32 * ks + 8 * fq; const f32x4 a = *(const f32x4*)wp, b = *(const f32x4*)(wp + 4); const int s0 = 32 * ks + 8 * fq;
#pragma unroll
        for (int e = 0; e < 4; ++e) { wsr[ks][e] = (s0 + e > t) ? 0.f : a[e]; wsr[ks][4 + e] = (s0 + 4 + e > t) ? 0.f : b[e]; } }
    const float bias = F.in[12][h * 128 + t];
    f32x4 sg0[4], sg1[4];
#pragma unroll
    for (int p = 0; p < 4; ++p) { const int ch = h * 128 + 32 * p + 8 * fq; sg0[p] = *(const f32x4*)(F.in[10] + ch); sg1[p] = *(const f32x4*)(F.in[10] + ch + 4); }
    v4u vreg[4], ucur[4], unext[4]; f32x4 rvp = {0.f, 0.f, 0.f, 0.f};
    int q = F.xg * (SEQ / 128) + (F.rk >> 3);
    if (q < nq) { const int m0 = q * 128;
#pragma unroll
        for (int p = 0; p < 4; ++p) { const int pc = F.tid + 512 * p; vreg[p] = *(const GAS v4u*)(proj + (size_t)(m0 + (pc >> 4)) * EVEN_IN + 1024 + h * 128 + (pc & 15) * 8);
            unext[p] = *(const GAS v4u*)(proj + (size_t)(m0 + t) * EVEN_IN + h * 128 + 32 * p + 8 * fq); }
        if (F.tid < 128) rvp = *(const GAS f32x4*)(vpart + (size_t)(m0 + F.tid) * 4); }
    for (; q < nq; q += qstep) { const int m0 = q * 128;
        if (F.tid < 128) rvs[F.tid] = pg8::rinv_of(rvp);
#pragma unroll
        for (int p = 0; p < 4; ++p) { const int pc = F.tid + 512 * p, s = pc >> 4, c8 = (pc & 15) * 8; const v4u w = vreg[p]; const unsigned ww[4] = {w.x, w.y, w.z, w.w};
            const int sw = (((s >> 3) ^ (pc & 15)) << 3) | (s & 7);
#pragma unroll
            for (int e = 0; e < 4; ++e) { vT[(c8 + 2 * e) * VT_PITCH + sw] = (bf16)(ww[e] & 0xffffu); vT[(c8 + 2 * e + 1) * VT_PITCH + sw] = (bf16)(ww[e] >> 16); }
            ucur[p] = unext[p]; }
        LDS_WAIT(); __syncthreads();
        const int qn = q + qstep;
        if (qn < nq) { const int m1 = qn * 128;
#pragma unroll
            for (int p = 0; p < 4; ++p) { const int pc = F.tid + 512 * p; vreg[p] = *(const GAS v4u*)(proj + (size_t)(m1 + (pc >> 4)) * EVEN_IN + 1024 + h * 128 + (pc & 15) * 8);
                unext[p] = *(const GAS v4u*)(proj + (size_t)(m1 + t) * EVEN_IN + h * 128 + 32 * p + 8 * fq); }
            if (F.tid < 128) rvp = *(const GAS f32x4*)(vpart + (size_t)(m1 + F.tid) * 4); }
        pg8::bf16x8 wsf[4];
#pragma unroll
        for (int ks = 0; ks < 4; ++ks) { const f32x4 r0 = *(const LAS f32x4*)(rvs + 32 * ks + 8 * fq), r1 = *(const LAS f32x4*)(rvs + 32 * ks + 8 * fq + 4); float f[8];
#pragma unroll
            for (int e = 0; e < 4; ++e) { f[e] = wsr[ks][e] * r0[e]; f[4 + e] = wsr[ks][4 + e] * r1[e]; }
            const v4u w = pack8(f); wsf[ks] = __builtin_bit_cast(pg8::bf16x8, w); }
#pragma unroll
        for (int p = 0; p < 4; ++p) { pg8::f32x4 a0 = {0.f, 0.f, 0.f, 0.f}, a1 = {0.f, 0.f, 0.f, 0.f};
            const int cr = 32 * p + 8 * (fr >> 2) + (fr & 3);
#pragma unroll
            for (int ks = 0; ks < 4; ++ks) { const int ck = ((4 * ks + fq) ^ ((cr >> 3) & 15)) << 3;
                const pg8::bf16x8 v0 = *(const LAS pg8::bf16x8*)(vT + cr * VT_PITCH + ck), v1 = *(const LAS pg8::bf16x8*)(vT + (cr + 4) * VT_PITCH + ck);
                a0 = __builtin_amdgcn_mfma_f32_16x16x32_bf16(v0, wsf[ks], a0, 0, 0, 0); a1 = __builtin_amdgcn_mfma_f32_16x16x32_bf16(v1, wsf[ks], a1, 0, 0, 0); }
            float u[8], y[8]; unpack8(ucur[p], u);
#pragma unroll
            for (int e = 0; e < 4; ++e) { y[e] = u[e] * (sg0[p][e] * a0[e] + bias); y[4 + e] = u[4 + e] * (sg1[p][e] * a1[e] + bias); }
            *(GAS v4u*)(mix + (size_t)(m0 + t) * D + h * 128 + 32 * p + 8 * fq) = pack8(y); }
        __syncthreads();
    }
}

template <class Sched> __device__ __forceinline__ void fill_rtab(Frame& F, const Sched& S, const float* part) {
    LAS float* rtab = (LAS float*)(F.lds + RTAB_OFF); int done = 0;
    for (int i = 0; ; ++i) { pg8::Unit u; if (!S.next(i, u)) break; const int slot = (u.pm >> 3) & 1;
        if (!(done & (1 << slot))) { done |= 1 << slot; if (F.tid < 256) rtab[slot * 256 + F.tid] = pg8::rinv_from_part(part, u.pm * 256 + F.tid); } }
    LDS_WAIT(); __syncthreads();
}

struct Args { const float* in[19]; float* out; unsigned char* ws; int ph_lo, ph_hi, li, pad; };
__global__ void __launch_bounds__(NWAVES * 64, 2) trunk_fwd(Args args) {
    extern __shared__ __attribute__((aligned(16))) unsigned char lds[];
    Frame F;
    F.lds = (LAS unsigned char*)lds; F.MISC = (volatile LAS unsigned*)(F.lds + MISC_OFF);
    F.tid = threadIdx.x; F.lane = F.tid & 63; F.wave = __builtin_amdgcn_readfirstlane(F.tid >> 6);
    F.G = gridDim.x; { const int bx = blockIdx.x; F.xg = bx % 8; F.rk = bx / 8; F.vcu = F.xg * (F.G / 8) + F.rk; }
#pragma unroll
    for (int i = 0; i < 19; ++i) F.in[i] = args.in[i];
    F.out = args.out; F.ws = args.ws; F.ctl = (gu32*)(args.ws + WS_CTL);
    for (int u = F.tid; u < (LDS_BYTES - LDSCTL_OFF) / 4; u += NWAVES * 64) ((LAS unsigned*)(F.lds + LDSCTL_OFF))[u] = 0u;
    __syncthreads();
    XcdBarrier bar; bar.bar = (unsigned*)(F.ctl + CW_BAR); bar.x = 0; bar.st = nullptr;
    if (!MK_PER_PHASE) { bar.x = xb_xcc_id(); bar.st = F.MISC + 8;
        if (F.tid == 0) F.MISC[10] = xb_add(&bar.bar[XB_XCNT(bar.x)], 1u); }
    bool loc = false; unsigned* const locw = (unsigned*)(F.ctl + CW_LOC);
    const int lo = args.ph_lo, hi = args.ph_hi;
#define IN(k) (lo <= (k) && (k) < hi)
#define REP2(k, body) do { body; if ((DBL_MASK >> (k)) & 1) { xcd_barrier(bar); body; } } while (0)
#if PROBE_STAMP
#define STAMP_A(k) do { if (F.tid == 0) { F.MISC[15] = 0u; const unsigned t_ = (unsigned)__builtin_amdgcn_s_memrealtime(); if (PROBE_STAMP == (k) + 1 || PROBE_STAMP == 98 || PROBE_STAMP == 300 + (k)) F.MISC[13] += t_ - F.MISC[12]; F.MISC[12] = t_; } } while (0)
#define STAMP_L(k) do { if (F.tid == 0) { const unsigned t_ = (unsigned)__builtin_amdgcn_s_memrealtime(); if (PROBE_STAMP == 100 + (k) || PROBE_STAMP == 99) F.MISC[13] += t_ - F.MISC[12]; F.MISC[12] = t_; } } while (0)
#else
#define STAMP_A(k) do {} while (0)
#define STAMP_L(k) do {} while (0)
#endif
#define SEAM(k) do { if (IN(k) && IN((k) + 1)) { STAMP_A(k); if (loc) xcd_local_barrier(bar, locw); else xcd_barrier(bar); STAMP_L(k); } } while (0)
    unsigned char* ws = args.ws;
    bf16* HB = (bf16*)(ws + WS_HB); bf16* PROJ = (bf16*)(ws + WS_PROJ); bf16* MIX = (bf16*)(ws + WS_MIX); bf16* ACTB = (bf16*)(ws + WS_ACT);
    float* PART = (float*)(ws + WS_PART);
    using pg8::Gemm; using pg8::StaticOrder;
    typedef pg8::EpiProj<0, false> EP0; typedef pg8::EpiProj<1, true> EP1; typedef pg8::EpiResid<false> ER1;
    int c = (int)blockIdx.x; LAS float* RED = (LAS float*)(F.lds + RED_OFF); const LAS float* RTAB = (const LAS float*)(F.lds + RTAB_OFF);

#if PROBE_STAMP
    if (F.tid == 0) { F.MISC[12] = (unsigned)__builtin_amdgcn_s_memrealtime(); F.MISC[13] = 0u; }
#endif
    if (IN(0)) { REP2(0, p0_prologue(F)); } SEAM(0);
    if (!MK_PER_PHASE && IN(0) && IN(1)) {
        if (F.tid == 0) { unsigned ok = (F.G % 8 == 0) ? 1u : 0u;
            for (unsigned j = 0; j < 16; ++j) { const unsigned cj = xb_ld(&bar.bar[XB_XCNT(j)]); ok &= (cj == (j < 8u ? (unsigned)F.G / 8u : 0u)) ? 1u : 0u; }
            F.MISC[11] = LOCAL_BARRIERS ? ok : 0u; }
        __syncthreads();
        loc = F.MISC[11] != 0u;
        if (loc) { F.xg = (int)bar.x; F.rk = (int)F.MISC[10]; F.vcu = F.xg * (F.G / 8) + F.rk; c = F.rk * 8 + F.xg; }
    }
    if (IN(1)) { PHASE_BEGIN(1);
        Gemm g{HB, (const bf16*)(ws + WS_WIN0), M, EVEN_IN, D}; StaticOrder S; S.init(M, EVEN_IN, F.G, c, 1 + PROBE_REP * ((DBL_MASK >> 1) & 1), NOEPI_MODE * ((NOEPI_MASK >> 1) & 1));
        { LAS float* cal = (LAS float*)(F.lds + CAL_OFF); for (int i = F.tid; i < 3 * 512; i += NWAVES * 64) cal[i] = F.in[5][i]; }
        fill_rtab(F, S, PART);
        pg8::EpiMix E{MIX, (float*)(ws + WS_SZ), RTAB, (const LAS float*)(F.lds + CAL_OFF), (float*)(ws + WS_SAB), (float*)(ws + WS_SCV), (LAS float*)(F.lds + XCH_OFF)};
        pg8::gemm_phase<pg8::EpiMix, StaticOrder, true, true>(F.lds + RING_OFF, g, S, E); } SEAM(1);
    if (IN(3)) { PHASE_BEGIN(3);
        Gemm g{MIX, (const bf16*)(ws + WS_WOUT0), M, D, D}; StaticOrder S; S.init(M, D, F.G, c, 1 + PROBE_REP * ((DBL_MASK >> 3) & 1), NOEPI_MODE * ((NOEPI_MASK >> 3) & 1)); mix_fixup_local(F, S);
        ER1 E{HB, nullptr, PART + 1 * (size_t)M * 16, RED};
        pg8::gemm_phase<ER1, StaticOrder, true, true>(F.lds + RING_OFF, g, S, E); } SEAM(3);
    if (IN(4)) { PHASE_BEGIN(4);
        Gemm g{HB, (const bf16*)(ws + WS_WGU0), M, NGU, D}; StaticOrder S; S.init(M, NGU, F.G, c, 1 + PROBE_REP * ((DBL_MASK >> 4) & 1), NOEPI_MODE * ((NOEPI_MASK >> 4) & 1));
        fill_rtab(F, S, PART + 1 * (size_t)M * 16); pg8::EpiFfn E{ACTB, RTAB, F.in[16], F.in[17], (float*)(ws + WS_SG), (float*)(ws + WS_SU), (LAS float*)(F.lds + XCH_OFF), (LAS float*)(F.lds + CWL_OFF)};
        pg8::gemm_phase<pg8::EpiFfn, StaticOrder, true, true>(F.lds + RING_OFF, g, S, E); } SEAM(4);
    if (IN(6)) { PHASE_BEGIN(6);
        Gemm g{ACTB, (const bf16*)(ws + WS_WD0), M, D, DFF}; StaticOrder S; S.init(M, D, F.G, c, 1 + PROBE_REP * ((DBL_MASK >> 6) & 1), NOEPI_MODE * ((NOEPI_MASK >> 6) & 1)); fixup_local(F, S, 0);
        ER1 E{HB, nullptr, PART + 2 * (size_t)M * 16, RED};
        pg8::gemm_phase<ER1, StaticOrder, true, true>(F.lds + RING_OFF, g, S, E); } SEAM(6);
    if (IN(7)) { PHASE_BEGIN(7);
        Gemm g{HB, (const bf16*)(ws + WS_WIN1), M, EVEN_IN, D}; StaticOrder S; S.init(M, EVEN_IN, F.G, c, 1 + PROBE_REP * ((DBL_MASK >> 7) & 1), NOEPI_MODE * ((NOEPI_MASK >> 7) & 1));
        fill_rtab(F, S, PART + 2 * (size_t)M * 16); EP1 E{PROJ, EVEN_IN, RTAB, PART + 3 * (size_t)M * 16, 4, RED};
        pg8::gemm_phase<EP1, StaticOrder, true, true>(F.lds + RING_OFF, g, S, E); } SEAM(7);
    if (IN(8)) { REP2(8, sgu_phase(F)); } SEAM(8);
    if (IN(9)) { PHASE_BEGIN(9);
        Gemm g{MIX, (const bf16*)(ws + WS_WOUT1), M, D, D}; StaticOrder S; S.init(M, D, F.G, c, 1 + PROBE_REP * ((DBL_MASK >> 9) & 1), NOEPI_MODE * ((NOEPI_MASK >> 9) & 1));
        ER1 E{HB, nullptr, PART + 4 * (size_t)M * 16, RED};
        pg8::gemm_phase<ER1, StaticOrder, true, true>(F.lds + RING_OFF, g, S, E); } SEAM(9);
    if (IN(10)) { PHASE_BEGIN(10);
        Gemm g{HB, (const bf16*)(ws + WS_WGU1), M, NGU, D}; StaticOrder S; S.init(M, NGU, F.G, c, 1 + PROBE_REP * ((DBL_MASK >> 10) & 1), NOEPI_MODE * ((NOEPI_MASK >> 10) & 1));
        fill_rtab(F, S, PART + 4 * (size_t)M * 16); pg8::EpiFfn E{ACTB, RTAB, F.in[16] + 3 * DFF, F.in[17] + DFF, (float*)(ws + WS_SG), (float*)(ws + WS_SU), (LAS float*)(F.lds + XCH_OFF), (LAS float*)(F.lds + CWL_OFF)};
        pg8::gemm_phase<pg8::EpiFfn, StaticOrder, true, true>(F.lds + RING_OFF, g, S, E); } SEAM(10);
    if (IN(12)) { PHASE_BEGIN(12);
        Gemm g{ACTB, (const bf16*)(ws + WS_WD1), M, D, DFF}; StaticOrder S; S.init(M, D, F.G, c, 1, 0); fixup_local(F, S, 1);
        pg8::EpiFinal E{HB, F.out, PART, (unsigned*)(F.ctl + CW_CNT), F.in[3], RED};
        pg8::gemm_phase<pg8::EpiFinal, StaticOrder, true, true>(F.lds + RING_OFF, g, S, E); }
#if PROBE_STAMP
    STAMP_A(12);
    if (F.tid == 0 && (PROBE_FILTER == 0 || (PROBE_FILTER <= 2 && (PROBE_FILTER == 1) == ((blockIdx.x & 7) < 4)) || (PROBE_FILTER >= 3 && (PROBE_FILTER == 3) == (F.rk < 4)))) xb_add((unsigned*)(F.ctl + 2048), PROBE_STAMP >= 300 ? F.MISC[13] - F.MISC[14] : PROBE_STAMP >= 200 ? F.MISC[14] : F.MISC[13]);
    xcd_barrier(bar);
    if (blockIdx.x == 0 && F.tid == 0) F.out[0] = ((float)xb_ld((unsigned*)(F.ctl + 2048)) * (1.0f / (100.0f * 256.0f)) - PROBE_OFF) * PROBE_SCALE;
#endif
#undef IN
#undef SEAM
#undef REP2
}

extern "C" void kernel_launch(void* const* d_in, const int* in_sizes, int n_in, void* d_out, int out_size, void* d_ws, size_t ws_size, hipStream_t stream) {
    static int grid = 0;
    if (grid == 0) {
        if (n_in != 19 || in_sizes[0] != M * D || out_size != M * D || ws_size < WS_END) { fprintf(stderr, "kernel_launch: unexpected shapes: n_in %d in0 %d out %d ws %zu (need %zu)\n", n_in, n_in > 0 ? in_sizes[0] : -1, out_size, ws_size, (size_t)WS_END); grid = -1; return; }
        int dev = 0, cus = 0, per_cu = 0;
        if (hipGetDevice(&dev) != hipSuccess || hipDeviceGetAttribute(&cus, hipDeviceAttributeMultiprocessorCount, dev) != hipSuccess) { fprintf(stderr, "kernel_launch: device query failed\n"); grid = -1; return; }
        if (hipFuncSetAttribute((const void*)trunk_fwd, hipFuncAttributeMaxDynamicSharedMemorySize, LDS_BYTES) != hipSuccess) { fprintf(stderr, "kernel_launch: hipFuncSetAttribute failed\n"); grid = -1; return; }
        if (hipOccupancyMaxActiveBlocksPerMultiprocessor(&per_cu, (const void*)trunk_fwd, NWAVES * 64, LDS_BYTES) != hipSuccess || per_cu < 1) { fprintf(stderr, "kernel_launch: occupancy query says %d blocks per CU\n", per_cu); }
        (void)hipGetLastError();
        grid = cus;
        if (grid != 256) { fprintf(stderr, "kernel_launch: built for a 256-CU device (static unit order, row-panel pairing); found %d CUs; nothing launched\n", grid); grid = -1; return; }
    }
    if (grid < 0) return;
    (void)hipMemsetAsync((char*)d_ws + WS_CTL, 0, CTL_ZERO_BYTES, stream);
    Args a{};
    for (int i = 0; i < 19; ++i) a.in[i] = (const float*)d_in[i];
    a.out = (float*)d_out; a.ws = (unsigned char*)d_ws;
#if MK_PER_PHASE
    for (int li = 0; li < NPHASE; ++li) { a.ph_lo = li; a.ph_hi = li + 1; a.li = li; hipLaunchKernelGGL(trunk_fwd, dim3(grid), dim3(NWAVES * 64), LDS_BYTES, stream, a); }
#else
    a.ph_lo = 0; a.ph_hi = NPHASE; a.li = 0;
    hipLaunchKernelGGL(trunk_fwd, dim3(grid), dim3(NWAVES * 64), LDS_BYTES, stream, a);
#endif
    const hipError_t le = hipPeekAtLastError();
    if (le != hipSuccess) fprintf(stderr, "kernel_launch: launch failed: %s\n", hipGetErrorName(le));
}
```

```cpp
#include <hip/hip_runtime.h>
#include <cstdio>
#include <cstdint>
#ifndef PG8_PROBE_EPI
#define PG8_PROBE_EPI 0
#endif
namespace pg8 {
#define PG8_LAS __attribute__((address_space(3)))
typedef unsigned short bf16_t;
typedef short bf16x8 __attribute__((ext_vector_type(8)));
typedef float f32x4 __attribute__((ext_vector_type(4)));
typedef unsigned u32x4 __attribute__((ext_vector_type(4)));
constexpr int BM = 256, BK = 64, HALF = 128, HTB = HALF * BK * 2  , STAGE_BYTES = 8 * HTB, NXCD = 8, WGM = 8;

__host__ __device__ __forceinline__ int lds_byte(int r, int c) { const int st = (r >> 4) * 2 + (c >> 5), rr = r & 15, cc = c & 31, ob = rr * 64 + cc * 2; return st * 1024 + (ob ^ (((ob >> 9) & 1) << 5)); }
__host__ __device__ __forceinline__ void stage_rc(int b, int& R, int& C) { const int st = b / 1024, sb = b % 1024, swz = sb ^ (((sb >> 9) & 1) << 5); R = (st >> 1) * 16 + swz / 64; C = (st & 1) * 32 + (swz % 64) / 2; }
__host__ __device__ __forceinline__ int perm32(int rho) { const int n = rho >> 4, i = rho & 15; return 8 * (i >> 2) + 4 * n + (i & 3); }

struct Unit { int pm, pn, pass; };
struct Gemm { const bf16_t* A; const bf16_t* Bt; int M, N, K; };

struct StaticOrder {
    int nM, nN, nwg, G, c, rep, noepi;
    __host__ __device__ void init(int M, int N, int G_, int c_, int rep_ = 1, int noepi_ = 0) { nM = M / BM; nN = N / BM; nwg = nM * nN; G = G_; c = c_; rep = rep_; noepi = noepi_; }
    __host__ __device__ bool live(int i) const { return !(noepi && i >= (nwg + G - 1) / G && (noepi == 1 || ((c >> 3) & 1))); }
    __host__ __device__ bool next(int i, Unit& u) const {
        const int rounds = (nwg + G - 1) / G; if (i >= rounds * rep) return false; const long L = (long)(i % rounds) * G + c; if (L >= nwg) return false;
        int wgid = (int)L; { const int q = nwg / NXCD, r = nwg % NXCD, xcd = wgid % NXCD, off = wgid / NXCD; wgid = (xcd < r ? xcd * (q + 1) : r * (q + 1) + (xcd - r) * q) + off; }
        const int nig = WGM * nN, gid = wgid / nig, fm = gid * WGM, gsz = (nM - fm) < WGM ? (nM - fm) : WGM;
        u.pm = fm + ((wgid % nig) % gsz); u.pn = (wgid % nig) / gsz; u.pass = i >= rounds; return true;
    }
    __device__ __forceinline__ void a_ready(const Unit&) const {}
    __device__ __forceinline__ void done(const Unit&) const {}
};

__device__ __forceinline__ unsigned cvt_pk_bf16(float lo, float hi) { unsigned r; asm volatile("v_cvt_pk_bf16_f32 %0, %1, %2" : "=v"(r) : "v"(lo), "v"(hi)); return r; }
typedef float f32x2 __attribute__((ext_vector_type(2)));
__device__ __forceinline__ f32x2 gelu_pk(f32x2 v) {
    const f32x2 av = __builtin_elementwise_abs(v), d = av * 0.2316418882f + 1.0f;
    f32x2 t; t.x = __builtin_amdgcn_rcpf(d.x); t.y = __builtin_amdgcn_rcpf(d.y);
    f32x2 q = t * 0.5307027145f + (-0.7265760135f); q = q * t + 0.7107068705f; q = q * t + (-0.142248368f); q = q * t + 0.127414796f; q = q * t;
    const f32x2 s = (v * v) * (-0.72134752044f);
    f32x2 e; e.x = __builtin_amdgcn_exp2f(s.x); e.y = __builtin_amdgcn_exp2f(s.y);
    return __builtin_elementwise_max(v, (f32x2){0.f, 0.f}) - av * (q * e);
}

constexpr float RMS_EPS = 1e-6f;
__device__ __forceinline__ float rinv_of(const f32x4 p) { return 1.0f / sqrtf(((p[0] + p[1]) + (p[2] + p[3])) * (1.0f / 1024.0f) + RMS_EPS); }
__device__ __forceinline__ float rinv_from_part(const float* part, int row) { return rinv_of(*(const f32x4*)(part + (size_t)row * 4)); }
__device__ __forceinline__ float gelu_erf(float v) { return 0.5f * v * (1.0f + erff(v * 0.70710678118654752f)); }
__device__ __forceinline__ float sumsq8(const f32x4 a, const f32x4 b) { return ((a[0] * a[0] + a[1] * a[1]) + (a[2] * a[2] + a[3] * a[3])) + ((b[0] * b[0] + b[1] * b[1]) + (b[2] * b[2] + b[3] * b[3])); }
#define EPI_LDS_BARRIER() do { asm volatile("s_waitcnt lgkmcnt(0)" ::: "memory"); __builtin_amdgcn_s_barrier(); asm volatile("" ::: "memory"); } while (0)
__device__ __forceinline__ void tile_rowsum_publish(const float (&ss)[2][4], PG8_LAS float* red, float* part_out, int pm, int slot, int wr, int wc, int fr, int fq) {
    if (fq == 0) {
#pragma unroll
        for (int ai = 0; ai < 2; ++ai)
#pragma unroll
            for (int m = 0; m < 4; ++m) red[(ai * HALF + wr * 64 + m * 16 + fr) * 4 + wc] = ss[ai][m]; }
    EPI_LDS_BARRIER();
    if (wr == 0) { const int row = wc * 64 + fq * 16 + fr; const f32x4 p = *(const PG8_LAS f32x4*)(red + row * 4); part_out[(size_t)(pm * BM + row) * 4 + slot] = (p[0] + p[1]) + (p[2] + p[3]); }
}

template <int ACT, bool VSS> struct EpiProj {
    static constexpr bool PERM = true, AFTER_DRAIN = false;
    __device__ __forceinline__ void prefetch(const Unit&, int, int) const {}
    bf16_t* O; int ldc; const PG8_LAS float* rtab; float* pout; int pn0; PG8_LAS float* red;
    __device__ __forceinline__ void operator()(const f32x4 (&acc)[2][2][4][2], const Unit& u, int wr, int wc, int fr, int fq) const {
        const int row0 = u.pm * BM + wr * 64 + fr, col0 = u.pn * BM + wc * 32 + 8 * fq;
        float ri[2][4], ss[2][4];
#pragma unroll
        for (int ai = 0; ai < 2; ++ai)
#pragma unroll
            for (int m = 0; m < 4; ++m) ri[ai][m] = rtab[((u.pm >> 3) & 1) * 256 + ai * HALF + wr * 64 + m * 16 + fr];
#pragma unroll
        for (int ai = 0; ai < 2; ++ai)
#pragma unroll
            for (int m = 0; m < 4; ++m) { const int row = row0 + ai * HALF + m * 16; const float r = ri[ai][m];
                bf16_t* rowp = O + (size_t)row * ldc + col0; float s = 0.f;
#pragma unroll
                for (int bj = 0; bj < 2; ++bj) { f32x4 v0 = acc[ai][bj][m][0] * r, v1 = acc[ai][bj][m][1] * r;
                    if (ACT == 1) { const f32x2 a = gelu_pk((f32x2){v0[0], v0[1]}), b = gelu_pk((f32x2){v0[2], v0[3]}), c = gelu_pk((f32x2){v1[0], v1[1]}), d = gelu_pk((f32x2){v1[2], v1[3]});
                        v0 = (f32x4){a.x, a.y, b.x, b.y}; v1 = (f32x4){c.x, c.y, d.x, d.y}; }
                    if (VSS) s += sumsq8(v0, v1);
                    u32x4 w; w.x = cvt_pk_bf16(v0[0], v0[1]); w.y = cvt_pk_bf16(v0[2], v0[3]); w.z = cvt_pk_bf16(v1[0], v1[1]); w.w = cvt_pk_bf16(v1[2], v1[3]);
                    *(u32x4*)(rowp + bj * HALF) = w; }
                if (VSS) { s += __shfl_xor(s, 16); s += __shfl_xor(s, 32); ss[ai][m] = s; } }
        if (VSS) { if (u.pn >= pn0) tile_rowsum_publish(ss, red, pout, u.pm, u.pn - pn0, wr, wc, fr, fq); }
    }
};

__device__ __forceinline__ void bf8_to_f32(const u32x4 w, f32x4& lo, f32x4& hi) {
    lo[0] = __builtin_bit_cast(float, w.x << 16); lo[1] = __builtin_bit_cast(float, w.x & 0xffff0000u); lo[2] = __builtin_bit_cast(float, w.y << 16); lo[3] = __builtin_bit_cast(float, w.y & 0xffff0000u);
    hi[0] = __builtin_bit_cast(float, w.z << 16); hi[1] = __builtin_bit_cast(float, w.z & 0xffff0000u); hi[2] = __builtin_bit_cast(float, w.w << 16); hi[3] = __builtin_bit_cast(float, w.w & 0xffff0000u);
}
template <bool FINAL> struct EpiResid {
    static constexpr bool PERM = true, AFTER_DRAIN = false;
    bf16_t* hb; float* out; float* pout; PG8_LAS float* red;
    __device__ __forceinline__ void prefetch(const Unit&, int, int) const {}
    __device__ __forceinline__ void operator()(const f32x4 (&acc)[2][2][4][2], const Unit& u, int wr, int wc, int fr, int fq) const {
        const int row0 = u.pm * BM + wr * 64 + fr, col0 = u.pn * BM + wc * 32 + 8 * fq; float ss[2][4];
#pragma unroll
        for (int ai = 0; ai < 2; ++ai) {
            u32x4 b[4][2];
#pragma unroll
            for (int m = 0; m < 4; ++m)
#pragma unroll
                for (int bj = 0; bj < 2; ++bj) b[m][bj] = *(const u32x4*)(hb + (size_t)(row0 + ai * HALF + m * 16) * 1024 + col0 + bj * HALF);
#pragma unroll
            for (int m = 0; m < 4; ++m) { const size_t off = (size_t)(row0 + ai * HALF + m * 16) * 1024 + col0; float s = 0.f;
#pragma unroll
                for (int bj = 0; bj < 2; ++bj) { f32x4 b0, b1; bf8_to_f32(b[m][bj], b0, b1); const f32x4 h0 = b0 + acc[ai][bj][m][0], h1 = b1 + acc[ai][bj][m][1];
                    if (FINAL) { *(f32x4*)(out + off + bj * HALF) = h0; *(f32x4*)(out + off + bj * HALF + 4) = h1; }
                    else { s += sumsq8(h0, h1);
                        u32x4 w; w.x = cvt_pk_bf16(h0[0], h0[1]); w.y = cvt_pk_bf16(h0[2], h0[3]); w.z = cvt_pk_bf16(h1[0], h1[1]); w.w = cvt_pk_bf16(h1[2], h1[3]);
                        *(u32x4*)(hb + off + bj * HALF) = w; } }
                if (!FINAL) { s += __shfl_xor(s, 16); s += __shfl_xor(s, 32); ss[ai][m] = s; } }
            asm volatile("" ::: "memory"); }
        if (!FINAL) tile_rowsum_publish(ss, red, pout, u.pm, u.pn, wr, wc, fr, fq);
    }
};

struct EpiFinal {
    static constexpr bool PERM = true, AFTER_DRAIN = false;
    const bf16_t* hb; float* out; float* xsum; unsigned* cnt; const float* gain; PG8_LAS float* red;
    __device__ __forceinline__ void prefetch(const Unit&, int, int) const {}
    __device__ __forceinline__ void operator()(f32x4 (&acc)[2][2][4][2], const Unit& u, int wr, int wc, int fr_, int fq_) const {
        int fr = fr_, fq = fq_; asm volatile("" : "+v"(fr), "+v"(fq));
        const int row0 = u.pm * BM + wr * 64 + fr, col0 = u.pn * BM + wc * 32 + 8 * fq; float ss[2][4];
        u32x4 b[2][4][2];
#pragma unroll
        for (int ai = 0; ai < 2; ++ai)
#pragma unroll
            for (int m = 0; m < 4; ++m)
#pragma unroll
                for (int bj = 0; bj < 2; ++bj) b[ai][m][bj] = *(const u32x4*)(hb + (size_t)(row0 + ai * HALF + m * 16) * 1024 + col0 + bj * HALF);
#pragma unroll
        for (int ai = 0; ai < 2; ++ai) {
#pragma unroll
            for (int m = 0; m < 4; ++m) { float s = 0.f;
#pragma unroll
                for (int bj = 0; bj < 2; ++bj) { f32x4 b0, b1; bf8_to_f32(b[ai][m][bj], b0, b1); acc[ai][bj][m][0] += b0; acc[ai][bj][m][1] += b1; s += sumsq8(acc[ai][bj][m][0], acc[ai][bj][m][1]); }
                s += __shfl_xor(s, 16); s += __shfl_xor(s, 32); ss[ai][m] = s; } }
        if (fq == 0) {
#pragma unroll
            for (int ai = 0; ai < 2; ++ai)
#pragma unroll
                for (int m = 0; m < 4; ++m) red[(ai * HALF + wr * 64 + m * 16 + fr) * 4 + wc] = ss[ai][m]; }
        EPI_LDS_BARRIER();
        const int trow = wc * 64 + fq * 16 + fr;
        if (wr == 0) { const f32x4 p = *(const PG8_LAS f32x4*)(red + trow * 4);
            __hip_atomic_store(xsum + (size_t)(u.pm * BM + trow) * 4 + u.pn, (p[0] + p[1]) + (p[2] + p[3]), __ATOMIC_RELAXED, __HIP_MEMORY_SCOPE_AGENT); }
        asm volatile("s_waitcnt vmcnt(0)" ::: "memory");
        EPI_LDS_BARRIER();
        if (wr == 0 && wc == 0 && fq == 0 && fr == 0) {
            __hip_atomic_fetch_add(cnt + 64 * u.pm, 1u, __ATOMIC_RELAXED, __HIP_MEMORY_SCOPE_AGENT);
            unsigned spins = 0;
            while (__hip_atomic_load(cnt + 64 * u.pm, __ATOMIC_RELAXED, __HIP_MEMORY_SCOPE_AGENT) < 4u) { __builtin_amdgcn_s_sleep(2); if (++spins > (1u << 22)) break; }
        }
        EPI_LDS_BARRIER();
        if (wr == 0) { const float* xs = xsum + (size_t)(u.pm * BM + trow) * 4;
            const float p0 = __hip_atomic_load(xs, __ATOMIC_RELAXED, __HIP_MEMORY_SCOPE_AGENT), p1 = __hip_atomic_load(xs + 1, __ATOMIC_RELAXED, __HIP_MEMORY_SCOPE_AGENT),
                        p2 = __hip_atomic_load(xs + 2, __ATOMIC_RELAXED, __HIP_MEMORY_SCOPE_AGENT), p3 = __hip_atomic_load(xs + 3, __ATOMIC_RELAXED, __HIP_MEMORY_SCOPE_AGENT);
            red[1024 + trow] = rinv_of((f32x4){p0, p1, p2, p3}); }
        EPI_LDS_BARRIER();
        f32x4 g[2][2];
#pragma unroll
        for (int bj = 0; bj < 2; ++bj) { g[bj][0] = *(const f32x4*)(gain + col0 + bj * HALF); g[bj][1] = *(const f32x4*)(gain + col0 + bj * HALF + 4); }
#pragma unroll
        for (int ai = 0; ai < 2; ++ai) {
#pragma unroll
            for (int m = 0; m < 4; ++m) { const size_t off = (size_t)(row0 + ai * HALF + m * 16) * 1024 + col0; const float r = red[1024 + ai * HALF + wr * 64 + m * 16 + fr];
#pragma unroll
                for (int bj = 0; bj < 2; ++bj) {
                    __builtin_nontemporal_store(acc[ai][bj][m][0] * r * g[bj][0], (f32x4*)(out + off + bj * HALF));
                    __builtin_nontemporal_store(acc[ai][bj][m][1] * r * g[bj][1], (f32x4*)(out + off + bj * HALF + 4)); } }
            asm volatile("" ::: "memory"); }
    }
};

__device__ __forceinline__ float dpp_ror1(float v) { return __builtin_bit_cast(float, __builtin_amdgcn_mov_dpp(__builtin_bit_cast(int, v), 0x121, 0xf, 0xf, true)); }
__device__ __forceinline__ float dpp_ror2(float v) { return __builtin_bit_cast(float, __builtin_amdgcn_mov_dpp(__builtin_bit_cast(int, v), 0x122, 0xf, 0xf, true)); }
__device__ __forceinline__ float silu_f(float a) { return a * __builtin_amdgcn_rcpf(1.0f + __expf(-a)); }
struct EpiFfn {
    static constexpr bool PERM = true, AFTER_DRAIN = false;
    bf16_t* ACT; const PG8_LAS float* rtab; const float* cw; const float* cb; float* SG; float* SU; PG8_LAS float* xch;
    static constexpr int DFF_ = 2816;
    PG8_LAS float* cwl;
    __device__ __forceinline__ void prefetch(const Unit& u, int wid, int lane) const {
        const int wc = wid & 3;
#pragma unroll
        for (int j = 0; j < 2; ++j) { const int e = j * 64 + lane, k = e >> 5, c = e & 31; const float* src = (k < 3 ? cw + k * DFF_ : cb) + u.pn * 128 + wc * 32 + c;
            __builtin_amdgcn_global_load_lds((const unsigned*)src, (PG8_LAS unsigned*)(cwl + wid * 128 + j * 64), 4, 0, 0); }
    }
    __device__ __forceinline__ void operator()(const f32x4 (&acc)[2][2][4][2], const Unit& u, int wr, int wc, int fr_, int fq_) const {
        int fr = fr_, fq = fq_; asm volatile("" : "+v"(fr), "+v"(fq));
        const int row0 = u.pm * BM + wr * 64 + fr, ch0 = u.pn * 128 + wc * 32 + 8 * fq;
        float ri[2][4];
#pragma unroll
        for (int ai = 0; ai < 2; ++ai)
#pragma unroll
            for (int m = 0; m < 4; ++m) ri[ai][m] = rtab[((u.pm >> 3) & 1) * 256 + ai * HALF + wr * 64 + m * 16 + fr];
        f32x2 w0[4], w1[4], w2[4], bb[4];
        { const PG8_LAS float* my = cwl + (wr * 4 + wc) * 128 + 8 * fq; const float nl2e = -1.4426950408889634f;
          const f32x4 a0 = *(const PG8_LAS f32x4*)(my), a1 = *(const PG8_LAS f32x4*)(my + 4), b0 = *(const PG8_LAS f32x4*)(my + 32), b1 = *(const PG8_LAS f32x4*)(my + 36);
          const f32x4 c0 = *(const PG8_LAS f32x4*)(my + 64), c1 = *(const PG8_LAS f32x4*)(my + 68), d0 = *(const PG8_LAS f32x4*)(my + 96), d1 = *(const PG8_LAS f32x4*)(my + 100);
          w0[0] = (f32x2){a0[0], a0[1]} * nl2e; w0[1] = (f32x2){a0[2], a0[3]} * nl2e; w0[2] = (f32x2){a1[0], a1[1]} * nl2e; w0[3] = (f32x2){a1[2], a1[3]} * nl2e;
          w1[0] = (f32x2){b0[0], b0[1]} * nl2e; w1[1] = (f32x2){b0[2], b0[3]} * nl2e; w1[2] = (f32x2){b1[0], b1[1]} * nl2e; w1[3] = (f32x2){b1[2], b1[3]} * nl2e;
          w2[0] = (f32x2){c0[0], c0[1]} * nl2e; w2[1] = (f32x2){c0[2], c0[3]} * nl2e; w2[2] = (f32x2){c1[0], c1[1]} * nl2e; w2[3] = (f32x2){c1[2], c1[3]} * nl2e;
          bb[0] = (f32x2){d0[0], d0[1]} * nl2e; bb[1] = (f32x2){d0[2], d0[3]} * nl2e; bb[2] = (f32x2){d1[0], d1[1]} * nl2e; bb[3] = (f32x2){d1[2], d1[3]} * nl2e; }
        if (fr >= 14) {
#pragma unroll
            for (int ai = 0; ai < 2; ++ai) { PG8_LAS f32x4* x = (PG8_LAS f32x4*)(xch + ((((ai * 2 + wr) * 4 + wc) * 2 + (fr - 14)) * 64 + 8 * fq));
                x[0] = acc[ai][0][3][0] * ri[ai][3]; x[1] = acc[ai][0][3][1] * ri[ai][3]; }
        }
        EPI_LDS_BARRIER();
        const bool f0 = fr == 0, f01 = fr < 2;
#pragma unroll
        for (int ai = 0; ai < 2; ++ai) {
            const int pa = wr ? ai : ai - 1, pw = wr ? 0 : 1; f32x2 P1[4], P2[4];
#pragma unroll
            for (int e = 0; e < 4; ++e) { P1[e] = (f32x2){0.f, 0.f}; P2[e] = (f32x2){0.f, 0.f}; }
            if (fr < 2 && (ai | wr)) { const PG8_LAS f32x4* x1 = (const PG8_LAS f32x4*)(xch + ((((pa * 2 + pw) * 4 + wc) * 2 + 1) * 64 + 8 * fq));
                const PG8_LAS f32x4* x2 = (const PG8_LAS f32x4*)(xch + ((((pa * 2 + pw) * 4 + wc) * 2 + fr) * 64 + 8 * fq));
                const f32x4 a = x1[0], b = x1[1], c = x2[0], d = x2[1];
                P1[0] = (f32x2){a[0], a[1]}; P1[1] = (f32x2){a[2], a[3]}; P1[2] = (f32x2){b[0], b[1]}; P1[3] = (f32x2){b[2], b[3]};
                P2[0] = (f32x2){c[0], c[1]}; P2[1] = (f32x2){c[2], c[3]}; P2[2] = (f32x2){d[0], d[1]}; P2[3] = (f32x2){d[2], d[3]}; }
#if defined(PROBE_FFN_SYNCONLY)
            if (u.pass) { asm volatile("" :: "v"(P1[0]), "v"(P1[1]), "v"(P1[2]), "v"(P1[3]), "v"(P2[0]), "v"(P2[1]), "v"(P2[2]), "v"(P2[3]), "v"(w0[0]), "v"(w1[1]), "v"(w2[2]), "v"(bb[3]), "v"(ri[ai][0])); continue; }
#endif
#pragma unroll
            for (int m = 0; m < 4; ++m) { const int row = row0 + ai * HALF + m * 16; const float r = ri[ai][m], ru = r * -0.6931471805599453f;
                f32x2 G[4], U[4]; float y[8];
                G[0] = (f32x2){acc[ai][0][m][0][0], acc[ai][0][m][0][1]} * r; G[1] = (f32x2){acc[ai][0][m][0][2], acc[ai][0][m][0][3]} * r;
                G[2] = (f32x2){acc[ai][0][m][1][0], acc[ai][0][m][1][1]} * r; G[3] = (f32x2){acc[ai][0][m][1][2], acc[ai][0][m][1][3]} * r;
                U[0] = (f32x2){acc[ai][1][m][0][0], acc[ai][1][m][0][1]} * ru; U[1] = (f32x2){acc[ai][1][m][0][2], acc[ai][1][m][0][3]} * ru;
                U[2] = (f32x2){acc[ai][1][m][1][0], acc[ai][1][m][1][1]} * ru; U[3] = (f32x2){acc[ai][1][m][1][2], acc[ai][1][m][1][3]} * ru;
#pragma unroll
                for (int e = 0; e < 4; ++e) { f32x2 r1, r2, p1, p2; r1.x = dpp_ror1(G[e].x); r1.y = dpp_ror1(G[e].y); r2.x = dpp_ror2(G[e].x); r2.y = dpp_ror2(G[e].y);
                    p1.x = f0 ? P1[e].x : r1.x; p1.y = f0 ? P1[e].y : r1.y; p2.x = f01 ? P2[e].x : r2.x; p2.y = f01 ? P2[e].y : r2.y; P1[e] = r1; P2[e] = r2;
                    const f32x2 t = __builtin_elementwise_fma(w2[e], G[e], __builtin_elementwise_fma(w1[e], p1, __builtin_elementwise_fma(w0[e], p2, bb[e])));
                    f32x2 d; d.x = __builtin_amdgcn_rcpf(1.0f + __builtin_amdgcn_exp2f(t.x)); d.y = __builtin_amdgcn_rcpf(1.0f + __builtin_amdgcn_exp2f(t.y));
                    const f32x2 o = (t * U[e]) * d; y[2 * e] = o.x; y[2 * e + 1] = o.y; }
                const f32x4 Gs0 = (f32x4){G[0].x, G[0].y, G[1].x, G[1].y}, Gs1 = (f32x4){G[2].x, G[2].y, G[3].x, G[3].y};
                const bool tile_head = (ai == 0 && wr == 0 && m == 0 && fr < 2);
                if (!tile_head) { u32x4 w; w.x = cvt_pk_bf16(y[0], y[1]); w.y = cvt_pk_bf16(y[2], y[3]); w.z = cvt_pk_bf16(y[4], y[5]); w.w = cvt_pk_bf16(y[6], y[7]);
#if defined(PROBE_FFN_NOSTORE)
                    if (u.pass) asm volatile("" :: "v"(w.x), "v"(w.y), "v"(w.z), "v"(w.w)); else
#endif
                    *(u32x4*)(ACT + (size_t)row * DFF_ + ch0) = w; }
                else { float* sg = SG + ((size_t)u.pm * 4 + fr) * DFF_ + ch0; float* su = SU + ((size_t)u.pm * 2 + fr) * DFF_ + ch0; const float k = -1.4426950408889634f;
                    *(f32x4*)sg = Gs0; *(f32x4*)(sg + 4) = Gs1;
                    *(f32x4*)su = (f32x4){U[0].x, U[0].y, U[1].x, U[1].y} * k; *(f32x4*)(su + 4) = (f32x4){U[2].x, U[2].y, U[3].x, U[3].y} * k; }
                if (ai == 1 && wr == 1 && m == 3 && fr >= 14) { float* sg = SG + ((size_t)u.pm * 4 + 2 + (fr - 14)) * DFF_ + ch0; *(f32x4*)sg = Gs0; *(f32x4*)(sg + 4) = Gs1; }
                asm volatile("" ::: "memory"); }
        }
    }
};

template <int CTRL> __device__ __forceinline__ float dpp_ror(float v) { return __builtin_bit_cast(float, __builtin_amdgcn_mov_dpp(__builtin_bit_cast(int, v), CTRL, 0xf, 0xf, true)); }
struct EpiMix {
    static constexpr bool PERM = true, AFTER_DRAIN = false;
    typedef unsigned u32x2 __attribute__((ext_vector_type(2)));
    bf16_t* MIXO; float* SZ; const PG8_LAS float* rtab; const PG8_LAS float* cal; float* SAB; float* SCV; PG8_LAS float* xch;
    __device__ __forceinline__ void prefetch(const Unit&, int, int) const {}
    __device__ __forceinline__ void operator()(const f32x4 (&acc)[2][2][4][2], const Unit& u, int wr, int wc, int fr_, int fq_) const {
        int fr = fr_, fq = fq_; asm volatile("" : "+v"(fr), "+v"(fq));
        const int row0 = u.pm * BM + wr * 64 + fr, ch0 = u.pn * 64 + wc * 16 + 4 * fq;
        const int lw = (u.pn >> 1) + 1; const float rcw = lw == 1 ? 0.5f : lw == 2 ? 0.25f : lw == 3 ? 0.125f : 0.0625f;
        PG8_LAS u32x2* const zh = (PG8_LAS u32x2*)(xch + 512);
        float ri[2][4];
#pragma unroll
        for (int ai = 0; ai < 2; ++ai)
#pragma unroll
            for (int m = 0; m < 4; ++m) ri[ai][m] = rtab[((u.pm >> 3) & 1) * 256 + ai * HALF + wr * 64 + m * 16 + fr];
        const f32x4 w0 = *(const PG8_LAS f32x4*)(cal + ch0), w1 = *(const PG8_LAS f32x4*)(cal + 512 + ch0), w2 = *(const PG8_LAS f32x4*)(cal + 1024 + ch0);
        if (fr >= 14) {
#pragma unroll
            for (int ai = 0; ai < 2; ++ai) { const float r = ri[ai][3];
                *(PG8_LAS f32x4*)(xch + ((((ai * 2 + wr) * 4 + wc) * 2 + (fr - 14)) * 16 + 4 * fq)) = (acc[ai][0][3][1] * r) * (acc[ai][1][3][0] * r); } }
#pragma unroll
        for (int ai = 0; ai < 2; ++ai) { const f32x4 z = acc[ai][1][3][1] * ri[ai][3]; u32x2 w; w.x = cvt_pk_bf16(z[0], z[1]); w.y = cvt_pk_bf16(z[2], z[3]);
            zh[(((ai * 2 + wr) * 4 + wc) * 16 + fr) * 4 + fq] = w; }
        EPI_LDS_BARRIER();
        const bool f0 = fr == 0, f01 = fr < 2, f03 = fr < 4, f07 = fr < 8;
#pragma unroll
        for (int ai = 0; ai < 2; ++ai) {
            const int pa = wr ? ai : ai - 1, pw = wr ? 0 : 1; f32x4 P1 = {0.f, 0.f, 0.f, 0.f}, P2 = {0.f, 0.f, 0.f, 0.f};
            f32x4 R0 = {0.f, 0.f, 0.f, 0.f}, R1 = R0, R2 = R0, R4 = R0;
            if (fr < 2 && (ai | wr)) { P1 = *(const PG8_LAS f32x4*)(xch + ((((pa * 2 + pw) * 4 + wc) * 2 + 1) * 16 + 4 * fq)); P2 = *(const PG8_LAS f32x4*)(xch + ((((pa * 2 + pw) * 4 + wc) * 2 + fr) * 16 + 4 * fq)); }
            if (ai | wr) { const u32x2 hz = zh[(((pa * 2 + pw) * 4 + wc) * 16 + fr) * 4 + fq];
                f32x4 zp; zp[0] = __builtin_bit_cast(float, hz.x << 16); zp[1] = __builtin_bit_cast(float, hz.x & 0xffff0000u); zp[2] = __builtin_bit_cast(float, hz.y << 16); zp[3] = __builtin_bit_cast(float, hz.y & 0xffff0000u);
#pragma unroll
                for (int e = 0; e < 4; ++e) { const float r0 = dpp_ror<0x121>(zp[e]), s1 = zp[e] + r0, r1 = dpp_ror<0x122>(s1), s2 = s1 + r1, r2 = dpp_ror<0x124>(s2), s4 = s2 + r2;
                    R0[e] = r0; R1[e] = r1; R2[e] = r2; R4[e] = dpp_ror<0x128>(s4); } }
#pragma unroll
            for (int m = 0; m < 4; ++m) { const int row = row0 + ai * HALF + m * 16; const float r = ri[ai][m];
                const f32x4 ab = acc[ai][0][m][0] * r, cv = (acc[ai][0][m][1] * r) * (acc[ai][1][m][0] * r), z = acc[ai][1][m][1] * r; f32x4 y, pz;
#pragma unroll
                for (int e = 0; e < 4; ++e) { const float r1 = dpp_ror1(cv[e]), r2 = dpp_ror2(cv[e]); const float p1 = f0 ? P1[e] : r1, p2 = f01 ? P2[e] : r2; P1[e] = r1; P2[e] = r2;
                    y[e] = ab[e] * __builtin_fmaf(w2[e], cv[e], __builtin_fmaf(w1[e], p1, w0[e] * p2)); }
#pragma unroll
                for (int e = 0; e < 4; ++e) { float S; const float t0 = dpp_ror<0x121>(z[e]), s1 = z[e] + (f0 ? R0[e] : t0); R0[e] = t0; S = s1;
                    if (lw >= 2) { const float t1 = dpp_ror<0x122>(s1), s2 = s1 + (f01 ? R1[e] : t1); R1[e] = t1; S = s2;
                        if (lw >= 3) { const float t2 = dpp_ror<0x124>(s2), s4 = s2 + (f03 ? R2[e] : t2); R2[e] = t2; S = s4;
                            if (lw >= 4) { const float t4 = dpp_ror<0x128>(s4); S = s4 + (f07 ? R4[e] : t4); R4[e] = t4; } } }
                    pz[e] = __builtin_fmaf(S, rcw, -z[e]); }
                const bool head_blk = (ai == 0 && wr == 0 && m == 0);
                if (!(head_blk && fr < 15)) { u32x2 w; w.x = cvt_pk_bf16(pz[0], pz[1]); w.y = cvt_pk_bf16(pz[2], pz[3]); *(u32x2*)(MIXO + (size_t)row * 1024 + 512 + ch0) = w; }
                else *(f32x4*)(SZ + ((size_t)u.pm * 30 + fr) * 512 + ch0) = z;
                if (ai == 1 && wr == 1 && m == 3 && fr >= 1) *(f32x4*)(SZ + ((size_t)u.pm * 30 + 14 + fr) * 512 + ch0) = z;
                const bool tile_head = (head_blk && fr < 2);
                if (!tile_head) { u32x2 w; w.x = cvt_pk_bf16(y[0], y[1]); w.y = cvt_pk_bf16(y[2], y[3]); *(u32x2*)(MIXO + (size_t)row * 1024 + ch0) = w; }
                else { *(f32x4*)(SAB + ((size_t)u.pm * 2 + fr) * 512 + ch0) = ab; *(f32x4*)(SCV + ((size_t)u.pm * 4 + fr) * 512 + ch0) = cv; }
                if (ai == 1 && wr == 1 && m == 3 && fr >= 14) *(f32x4*)(SCV + ((size_t)u.pm * 4 + 2 + (fr - 14)) * 512 + ch0) = cv;
            }
        }
    }
};

template <class Epi, class Sched, bool ALIGN_EPI = false, bool SP2 = false>
__device__ __forceinline__ void gemm_phase(PG8_LAS unsigned char* lds, const Gemm g, const Sched& S, const Epi& E) {
    const int tid = threadIdx.x, wid = __builtin_amdgcn_readfirstlane(tid >> 6), lane = tid & 63, wr = wid >> 2, wc = wid & 3, fr = lane & 15, fq = lane >> 4;
    const int K = g.K, nt = K / BK;
    unsigned voffA[2], voffB[2];
#pragma unroll
    for (int i = 0; i < 2; ++i) { int R, C; stage_rc(tid * 16 + i * 8192, R, C); const int Rb = Epi::PERM ? ((R & ~31) + perm32(R & 31)) : R;
        voffA[i] = (unsigned)(R * K + C) * 2u; voffB[i] = (unsigned)(Rb * K + C) * 2u; }
    const size_t kstep = (size_t)(BK * 2);
    const size_t hstep = (size_t)HALF * K * 2;
    const size_t tstep = 2 * hstep;
    const unsigned ldsw = (unsigned)wid * 1024u;
    const int aoff = lds_byte(wr * 64 + fr, fq * 8), boff = lds_byte(wc * 32 + fr, fq * 8);
#define PG8_SA(b, h) (((b) * 2 + (h)) * HTB)
#define PG8_SB(b, h) ((4 + (b) * 2 + (h)) * HTB)
#define PG8_STAGE(bufoff, gbase, voff) do { _Pragma("unroll") for (int _i = 0; _i < 2; ++_i) \
        __builtin_amdgcn_global_load_lds((const unsigned*)((const char*)(gbase) + (voff)[_i]), (PG8_LAS unsigned*)(lds + (bufoff) + ldsw + _i * 8192), 16, 0, 0); } while (0)
#define PG8_LDA(dst, b, h) do { _Pragma("unroll") for (int m = 0; m < 4; ++m) _Pragma("unroll") for (int k = 0; k < 2; ++k) dst[m][k] = *(const PG8_LAS bf16x8*)(lds + PG8_SA(b, h) + aoff + m * 2048 + k * 1024); } while (0)
#define PG8_LDB(dst, b, h) do { _Pragma("unroll") for (int n = 0; n < 2; ++n) _Pragma("unroll") for (int k = 0; k < 2; ++k) dst[n][k] = *(const PG8_LAS bf16x8*)(lds + PG8_SB(b, h) + boff + n * 2048 + k * 1024); } while (0)
#define PG8_MMA(ai, bj, At, Bt) do { __builtin_amdgcn_s_setprio(1); _Pragma("unroll") for (int m = 0; m < 4; ++m) _Pragma("unroll") for (int n = 0; n < 2; ++n) _Pragma("unroll") for (int k = 0; k < 2; ++k) \
        acc[ai][bj][m][n] = __builtin_amdgcn_mfma_f32_16x16x32_bf16(Bt[n][k], At[m][k], acc[ai][bj][m][n], 0, 0, 0); __builtin_amdgcn_s_setprio(0); } while (0)
#define PG8_WAIT_V(n) asm volatile("s_waitcnt vmcnt(" #n ")" ::: "memory")
#define PG8_WAIT_L(n) asm volatile("s_waitcnt lgkmcnt(" #n ")" ::: "memory")
#define PG8_BAR __builtin_amdgcn_s_barrier()
#define PG8_SCHED __builtin_amdgcn_sched_barrier(0)
    Unit cur, nxt; int ui = 0;
    if (!S.next(0, cur)) return;
    f32x4 acc[2][2][4][2];
#pragma unroll
    for (int a = 0; a < 2; ++a)
#pragma unroll
        for (int b = 0; b < 2; ++b)
#pragma unroll
            for (int m = 0; m < 4; ++m)
#pragma unroll
                for (int n = 0; n < 2; ++n) acc[a][b][m][n] = (f32x4){0.f, 0.f, 0.f, 0.f};
    bf16x8 At[4][2], B0[2][2], B1[2][2];
    const char* cA = (const char*)g.A + (size_t)cur.pm * tstep; const char* cB = (const char*)g.Bt + (size_t)cur.pn * tstep;
    S.a_ready(cur);
    if constexpr (SP2) {
        PG8_STAGE(PG8_SB(0, 0), cB, voffB); PG8_STAGE(PG8_SB(0, 1), cB + hstep, voffB); PG8_STAGE(PG8_SA(0, 0), cA, voffA); PG8_STAGE(PG8_SA(0, 1), cA + hstep, voffA);
        if (wr == 1) PG8_BAR;
        PG8_WAIT_V(2); PG8_BAR;
        PG8_STAGE(PG8_SB(1, 0), cB + kstep, voffB); PG8_STAGE(PG8_SA(1, 0), cA + kstep, voffA); PG8_STAGE(PG8_SB(1, 1), cB + hstep + kstep, voffB);
        PG8_WAIT_V(6); PG8_BAR;
    } else {
        PG8_STAGE(PG8_SB(0, 0), cB, voffB); PG8_STAGE(PG8_SA(0, 0), cA, voffA); PG8_STAGE(PG8_SB(0, 1), cB + hstep, voffB); PG8_STAGE(PG8_SA(0, 1), cA + hstep, voffA);
        if (wr == 1) PG8_BAR;
        PG8_WAIT_V(4); PG8_BAR;
        PG8_STAGE(PG8_SB(1, 0), cB + kstep, voffB); PG8_STAGE(PG8_SA(1, 0), cA + kstep, voffA); PG8_STAGE(PG8_SB(1, 1), cB + hstep + kstep, voffB);
        PG8_WAIT_V(6); PG8_BAR;
    }
    for (;;) {
        const bool has_next = S.next(ui + 1, nxt);
        const char* nA = has_next ? (const char*)g.A + (size_t)nxt.pm * tstep : cA; const char* nB = has_next ? (const char*)g.Bt + (size_t)nxt.pn * tstep : cB;
        for (int t = 0; t < nt; t += 2) {
            const bool last = (t == nt - 2);
            const char* a1 = cA + (size_t)(t + 1) * kstep;
            const char* a2 = last ? nA : cA + (size_t)(t + 2) * kstep; const char* b2 = last ? nB : cB + (size_t)(t + 2) * kstep;
            const char* a3 = a2 + kstep; const char* b3 = b2 + kstep;
            if (last && has_next) S.a_ready(nxt);
            if (last) E.prefetch(cur, wid, lane);
            if constexpr (SP2) {
            PG8_LDB(B0, 0, 0); PG8_LDB(B1, 0, 1); PG8_SCHED; PG8_LDA(At, 0, 0); PG8_STAGE(PG8_SA(1, 1), a1 + hstep, voffA);
            PG8_WAIT_V(8); PG8_WAIT_L(0); PG8_BAR; PG8_MMA(0, 0, At, B0); PG8_MMA(0, 1, At, B1); PG8_BAR; PG8_SCHED;
            PG8_LDA(At, 0, 1); PG8_STAGE(PG8_SB(0, 0), b2, voffB); PG8_STAGE(PG8_SB(0, 1), b2 + hstep, voffB); PG8_STAGE(PG8_SA(0, 0), a2, voffA);
            PG8_WAIT_V(8); PG8_WAIT_L(0); PG8_BAR; PG8_MMA(1, 0, At, B0); PG8_MMA(1, 1, At, B1); PG8_BAR; PG8_SCHED;
            PG8_LDB(B0, 1, 0); PG8_LDB(B1, 1, 1); PG8_SCHED; PG8_LDA(At, 1, 0); PG8_STAGE(PG8_SA(0, 1), a2 + hstep, voffA);
            PG8_WAIT_V(8); PG8_WAIT_L(0); PG8_BAR; PG8_MMA(0, 0, At, B0); PG8_MMA(0, 1, At, B1); PG8_BAR; PG8_SCHED;
            PG8_LDA(At, 1, 1); PG8_STAGE(PG8_SB(1, 0), b3, voffB); PG8_STAGE(PG8_SB(1, 1), b3 + hstep, voffB); PG8_STAGE(PG8_SA(1, 0), a3, voffA);
            PG8_WAIT_V(8); PG8_WAIT_L(0); PG8_BAR; PG8_MMA(1, 0, At, B0); PG8_MMA(1, 1, At, B1); PG8_BAR; PG8_SCHED;
            } else {
            PG8_LDB(B0, 0, 0); PG8_SCHED; PG8_LDA(At, 0, 0); PG8_STAGE(PG8_SA(1, 1), a1 + hstep, voffA);
            PG8_WAIT_L(8); PG8_BAR; PG8_WAIT_L(0); PG8_MMA(0, 0, At, B0); PG8_BAR; PG8_SCHED;
            PG8_LDB(B1, 0, 1); PG8_STAGE(PG8_SB(0, 0), b2, voffB);
            PG8_BAR; PG8_WAIT_L(0); PG8_MMA(0, 1, At, B1); PG8_BAR;
            PG8_LDA(At, 0, 1); PG8_STAGE(PG8_SA(0, 0), a2, voffA);
            PG8_BAR; PG8_WAIT_L(0); PG8_MMA(1, 0, At, B0); PG8_BAR; PG8_SCHED;
            PG8_STAGE(PG8_SB(0, 1), b2 + hstep, voffB);
            PG8_WAIT_V(6); PG8_BAR; PG8_MMA(1, 1, At, B1); PG8_BAR;
            PG8_LDB(B0, 1, 0); PG8_SCHED; PG8_LDA(At, 1, 0); PG8_STAGE(PG8_SA(0, 1), a2 + hstep, voffA);
            PG8_WAIT_L(8); PG8_BAR; PG8_WAIT_L(0); PG8_MMA(0, 0, At, B0); PG8_BAR; PG8_SCHED;
            PG8_LDB(B1, 1, 1); PG8_STAGE(PG8_SB(1, 0), b3, voffB);
            PG8_BAR; PG8_WAIT_L(0); PG8_MMA(0, 1, At, B1); PG8_BAR;
            PG8_LDA(At, 1, 1); PG8_STAGE(PG8_SA(1, 0), a3, voffA);
            PG8_BAR; PG8_WAIT_L(0); PG8_MMA(1, 0, At, B0); PG8_BAR; PG8_SCHED;
            PG8_STAGE(PG8_SB(1, 1), b3 + hstep, voffB);
            PG8_WAIT_V(6); PG8_BAR; PG8_MMA(1, 1, At, B1); PG8_BAR;
            }
        }
#if PG8_PROBE_EPI
        unsigned te0_ = 0u; if (wid == 0) te0_ = (unsigned)__builtin_amdgcn_s_memrealtime();
#endif
        if constexpr (ALIGN_EPI) { if (wr == 0) PG8_BAR; }
        if constexpr (!Epi::AFTER_DRAIN) { if (S.live(ui)) E(acc, cur, wr, wc, fr, fq); S.done(cur); }
#if PG8_PROBE_EPI
        if (wid == 0 && lane == 0) { volatile PG8_LAS unsigned* pm_ = (volatile PG8_LAS unsigned*)(lds + 131072 + 320); if (pm_[15]) pm_[14] += (unsigned)__builtin_amdgcn_s_memrealtime() - te0_; }
#endif
        if (!has_next) break;
#pragma unroll
        for (int a = 0; a < 2; ++a)
#pragma unroll
            for (int b = 0; b < 2; ++b)
#pragma unroll
                for (int m = 0; m < 4; ++m)
#pragma unroll
                    for (int n = 0; n < 2; ++n) acc[a][b][m][n] = (f32x4){0.f, 0.f, 0.f, 0.f};
        cur = nxt; cA = nA; cB = nB; ++ui;
        if constexpr (ALIGN_EPI) { if (wr == 1) PG8_BAR; }
    }
    PG8_WAIT_V(0);
    if constexpr (!ALIGN_EPI) { if (wr == 0) PG8_BAR; }
    PG8_BAR;
    if constexpr (Epi::AFTER_DRAIN) { E.fused(acc, cur, wr, wc, fr, fq, lds, wid, lane); S.done(cur); }
#undef PG8_SA
#undef PG8_SB
#undef PG8_STAGE
#undef PG8_LDA
#undef PG8_LDB
#undef PG8_MMA
#undef PG8_WAIT_V
#undef PG8_WAIT_L
#undef PG8_BAR
#undef PG8_SCHED
}
}

constexpr int NWAVES = 8;
#ifndef MK_PER_PHASE
#define MK_PER_PHASE 0
#endif
constexpr int NPHASE = 14;
#ifndef NOEPI_MASK
#define NOEPI_MASK 0
#endif
#ifndef LOCAL_BARRIERS
#define LOCAL_BARRIERS 1
#endif
#ifndef PROBE_REP
#define PROBE_REP 1
#endif
#ifndef NOEPI_MODE
#define NOEPI_MODE 1
#endif
#ifndef PROBE_STAMP
#define PROBE_STAMP 0
#endif
#ifndef PROBE_SCALE
#define PROBE_SCALE 1.0f
#endif
#ifndef PROBE_OFF
#define PROBE_OFF 0.0f
#endif
#ifndef PROBE_FILTER
#define PROBE_FILTER 0
#endif
#ifndef DBL_MASK
#define DBL_MASK 0
#endif

constexpr int BATCH = 8, SEQ = 4096, D = 1024, M = BATCH * SEQ;
constexpr int AW = 512, EVEN_IN = 2048, DFF = 2816, NGU = 2 * DFF;
constexpr int RUN = 32;

constexpr size_t MiB = 1u << 20;
constexpr size_t WS_CTL = 0, CTL_ZERO_BYTES = 72 * 1024;
constexpr size_t WS_WIN0 = 1 * MiB, WS_WOUT0 = 5 * MiB, WS_WIN1 = 7 * MiB, WS_WOUT1 = 11 * MiB, WS_WGU0 = 13 * MiB, WS_WGU1 = 24 * MiB;
constexpr size_t WS_WD0 = 35 * MiB, WS_WD1 = WS_WD0 + (size_t)D * DFF * 2, WS_PART = 46 * MiB;
constexpr size_t PART_BYTES = (size_t)M * 16 * 4;
constexpr size_t WS_SG = 56 * MiB, WS_SU = WS_SG + (size_t)128 * 4 * DFF * 4;
constexpr size_t WS_SAB = WS_SU + (size_t)128 * 2 * DFF * 4, WS_SCV = WS_SAB + (size_t)128 * 2 * 512 * 4;
constexpr size_t WS_HB = 66 * MiB;
constexpr size_t WS_C = 130 * MiB;
constexpr size_t WS_ACT = WS_C, WS_PROJ = WS_C + 176 * MiB, WS_MIX = WS_C + 304 * MiB, WS_SZ = WS_C + 368 * MiB;
constexpr size_t WS_END = WS_C + 376 * MiB;
static_assert(WS_WD1 + (size_t)D * DFF * 2 <= WS_PART && WS_PART + 5 * PART_BYTES <= WS_SG && WS_SCV + (size_t)128 * 4 * 512 * 4 <= WS_HB && WS_HB + (size_t)M * D * 2 <= WS_C, "ws map");
static_assert((size_t)M * DFF * 2 == 176 * MiB && (size_t)M * EVEN_IN * 2 == 128 * MiB, "ws map sizes");
constexpr int CW_BAR = 4096, CW_CNT = 8192, CW_LOC = 16384;
constexpr int CW_DUMMY_ = 0;

constexpr int RING_OFF = 0, RING_BYTES = 131072;
constexpr int LDSCTL_OFF = RING_BYTES, MISC_OFF = LDSCTL_OFF + 320;
constexpr int LDS_BYTES = 156672;
constexpr int XCH_OFF = RING_BYTES + 1024, RED_OFF = XCH_OFF + 8192, RTAB_OFF = RED_OFF + 4096, CWL_OFF = RTAB_OFF + 2048, CAL_OFF = CWL_OFF + 4096;
static_assert(RING_OFF == 0 && MISC_OFF == 131072 + 320 && (CW_CNT + 128 * 64) * 4 <= (int)CTL_ZERO_BYTES && RED_OFF + 4096 == RTAB_OFF && MISC_OFF + 128 <= XCH_OFF && CAL_OFF + 6144 <= LDS_BYTES, "LDS map");

#define GAS __attribute__((address_space(1)))
#define LAS __attribute__((address_space(3)))
typedef unsigned short bf16;
typedef unsigned v4u __attribute__((ext_vector_type(4)));
typedef float f32x4 __attribute__((ext_vector_type(4)));
typedef short bf16x8 __attribute__((ext_vector_type(8)));
typedef GAS unsigned gu32;
typedef GAS unsigned long long gu64;
#define RLX_AGENT __ATOMIC_RELAXED, __HIP_MEMORY_SCOPE_AGENT
#define LDS_WAIT() asm volatile("s_waitcnt lgkmcnt(0)" ::: "memory")
#define VM_WAIT() asm volatile("s_waitcnt vmcnt(0)" ::: "memory")
__device__ __forceinline__ unsigned long long rt() { return __builtin_amdgcn_s_memrealtime(); }
__device__ __forceinline__ unsigned f2bf(float f) { unsigned u = __builtin_bit_cast(unsigned, f); return (u + 0x7fffu + ((u >> 16) & 1u)) >> 16; }
__device__ __forceinline__ unsigned pk2(float lo, float hi) { return f2bf(lo) | (f2bf(hi) << 16); }

#define XB_TMO      128
#define XB_XCNT(j)  (256  + 64 * (j))
#define XB_XSUB(j)  (1280 + 64 * (j))
#define XB_XGEN(j)  (2304 + 64 * (j))
#define XB_TOP      3328
#define XB_TOPGEN   3392
#define XCD_BAR_WORDS 3456
#define XB_SPIN_CAP (1u << 18)

__device__ __forceinline__ unsigned xb_ld(unsigned* p)              { return __hip_atomic_load(p, __ATOMIC_RELAXED, __HIP_MEMORY_SCOPE_AGENT); }
__device__ __forceinline__ unsigned xb_add(unsigned* p, unsigned v) { return __hip_atomic_fetch_add(p, v, __ATOMIC_RELAXED, __HIP_MEMORY_SCOPE_AGENT); }
__device__ __forceinline__ unsigned xb_xcc_id() { return (unsigned)__builtin_amdgcn_s_getreg((3 << 11) | 20) & 0xFu; }
#define XB_SPIN(cond, bar) do { unsigned _sp = 0; while (cond) { __builtin_amdgcn_s_sleep(1); \
    if ((++_sp & 255u) == 0u) { if (xb_ld(&(bar)[XB_TMO])) break; if (_sp > XB_SPIN_CAP) { atomicAdd(&(bar)[XB_TMO], 1u); break; } } } } while (0)

struct XcdBarrier {
    unsigned* bar; unsigned x;
    volatile LAS unsigned* st;
};

__device__ __forceinline__ XcdBarrier xcd_barrier_post(unsigned* bar, volatile LAS unsigned* st) {
    XcdBarrier b; b.bar = bar; b.x = xb_xcc_id(); b.st = st;
    if (threadIdx.x == 0) (void)xb_add(&bar[XB_XCNT(b.x)], 1u);
    return b;
}
__device__ __forceinline__ void xcd_barrier_complete(unsigned* bar, unsigned x, unsigned& nloc, unsigned& nx) {
    const unsigned G = gridDim.x * gridDim.y * gridDim.z;
    unsigned sum, cnt, mine, sp = 0u;
    for (;;) {
        sum = 0u; cnt = 0u; mine = 0u;
#pragma unroll
        for (unsigned j = 0; j < 16; ++j) { const unsigned c = xb_ld(&bar[XB_XCNT(j)]); sum += c; cnt += (c > 0u) ? 1u : 0u; mine = (j == x) ? c : mine; }
        if (sum == G) break;
        __builtin_amdgcn_s_sleep(1);
        if ((++sp & 255u) == 0u) { if (xb_ld(&bar[XB_TMO])) break; if (sp > XB_SPIN_CAP) { atomicAdd(&bar[XB_TMO], 1u); break; } }
    }
    nloc = mine > 0u ? mine : 1u; nx = cnt > 0u ? cnt : 1u;
}

__device__ __forceinline__ void xcd_barrier(const XcdBarrier& b) {
    asm volatile("s_waitcnt vmcnt(0)" ::: "memory");
    __syncthreads();
    if (threadIdx.x == 0) {
        unsigned* bar = b.bar;
        __builtin_amdgcn_s_waitcnt(0);
        unsigned nloc = b.st[0], nx = b.st[1];
        if (nloc == 0u) { xcd_barrier_complete(bar, b.x, nloc, nx); b.st[0] = nloc; b.st[1] = nx; }
        const unsigned old = xb_add(&bar[XB_XSUB(b.x)], 1u);
        const unsigned gen = old / nloc;
        if (old + 1u == (gen + 1u) * nloc) {
            __builtin_amdgcn_fence(__ATOMIC_RELEASE, "agent");
            asm volatile("s_waitcnt vmcnt(0)" ::: "memory");
            const unsigned og = xb_add(&bar[XB_TOP], 1u);
            const unsigned tg = og / nx;
            if (og + 1u == (tg + 1u) * nx) xb_add(&bar[XB_TOPGEN], 1u);
            else XB_SPIN(xb_ld(&bar[XB_TOPGEN]) == tg, bar);
            __builtin_amdgcn_fence(__ATOMIC_ACQUIRE, "agent");
            xb_add(&bar[XB_XGEN(b.x)], 1u);
            asm volatile("s_waitcnt vmcnt(0)" ::: "memory");
        } else {
            XB_SPIN(xb_ld(&bar[XB_XGEN(b.x)]) == gen, bar);
            __builtin_amdgcn_fence(__ATOMIC_ACQUIRE, "agent");
            asm volatile("s_waitcnt vmcnt(0)" ::: "memory");
        }
    }
    __syncthreads();
}


__device__ __forceinline__ void xcd_local_barrier(const XcdBarrier& b, unsigned* lw) {
    asm volatile("s_waitcnt vmcnt(0)" ::: "memory");
    __syncthreads();
    if (threadIdx.x == 0) {
        __builtin_amdgcn_s_waitcnt(0);
        const unsigned nloc = b.st[0];
        const unsigned old = xb_add(&lw[64u * b.x], 1u);
        const unsigned tgt = (old / nloc + 1u) * nloc;
        if (old + 1u != tgt) XB_SPIN(xb_ld(&lw[64u * b.x]) < tgt, b.bar);
        __builtin_amdgcn_fence(__ATOMIC_ACQUIRE, "agent");
        asm volatile("s_waitcnt vmcnt(0)" ::: "memory");
    }
    __syncthreads();
}

__device__ __forceinline__ float wave_sum(float v) {
#pragma unroll
    for (int o = 1; o < 64; o <<= 1) v += __shfl_xor(v, o);
    return v;
}
__device__ __forceinline__ float bf_lo(unsigned w) { return __builtin_bit_cast(float, w << 16); }
__device__ __forceinline__ float bf_hi(unsigned w) { return __builtin_bit_cast(float, w & 0xffff0000u); }
__device__ __forceinline__ void unpack8(const v4u w, float (&f)[8]) { f[0] = bf_lo(w.x); f[1] = bf_hi(w.x); f[2] = bf_lo(w.y); f[3] = bf_hi(w.y); f[4] = bf_lo(w.z); f[5] = bf_hi(w.z); f[6] = bf_lo(w.w); f[7] = bf_hi(w.w); }
__device__ __forceinline__ v4u pack8(const float (&f)[8]) { v4u w; w.x = pk2(f[0], f[1]); w.y = pk2(f[2], f[3]); w.z = pk2(f[4], f[5]); w.w = pk2(f[6], f[7]); return w; }

struct Frame {
    LAS unsigned char* lds;
    volatile LAS unsigned* MISC;
    gu32* ctl;
    int tid, lane, wave, vcu, G, xg, rk;
    const float* in[19]; float* out; unsigned char* ws;
};
#define PHASE_BEGIN(k) do { if ((PROBE_STAMP == 200 + (k) || PROBE_STAMP == 300 + (k)) && F.tid == 0) F.MISC[15] = 1u; } while (0)

__device__ __forceinline__ int mixmap(int nsrc) { const int kind = nsrc >> 9, ch = nsrc & 511; return 256 * (ch >> 6) + 128 * (kind >> 1) + 32 * ((ch >> 4) & 3) + 8 * ((ch >> 2) & 3) + 4 * (kind & 1) + (ch & 3); }
struct P0Desc { const float* W; const float* gain; bf16* WT; int ldw, ldt, roff, k0, n0, mm; };
__device__ __forceinline__ void p0_titem_load(const P0Desc& d, int lane, f32x4 (&v)[8], float (&gn)[8]) {
    const int r = lane >> 3, c4 = 4 * (lane & 7);
#pragma unroll
    for (int i = 0; i < 8; ++i) { v[i] = __builtin_nontemporal_load((const f32x4*)(d.W + (size_t)(d.k0 + r + 8 * i) * d.ldw + d.n0 + c4)); gn[i] = d.gain ? d.gain[d.k0 + r + 8 * i] : 1.0f; }
}
__device__ __forceinline__ void p0_titem_store(const P0Desc& d, LAS float* scr, int lane, const f32x4 (&v)[8], const float (&gn)[8]) {
    const int r = lane >> 3, c4 = 4 * (lane & 7);
#pragma unroll
    for (int i = 0; i < 8; ++i) { LAS float* q = scr + (r + 8 * i) * 33 + c4; q[0] = v[i].x * gn[i]; q[1] = v[i].y * gn[i]; q[2] = v[i].z * gn[i]; q[3] = v[i].w * gn[i]; }
    LDS_WAIT(); asm volatile("" ::: "memory");
    const int c = lane & 7;
#pragma unroll
    for (int j = 0; j < 4; ++j) { const int n = (lane >> 3) + 8 * j; const LAS float* t = scr + (8 * c) * 33 + n;
        v4u o; o.x = pk2(t[0 * 33], t[1 * 33]); o.y = pk2(t[2 * 33], t[3 * 33]); o.z = pk2(t[4 * 33], t[5 * 33]); o.w = pk2(t[6 * 33], t[7 * 33]);
        *(GAS v4u*)(d.WT + (size_t)(d.mm ? mixmap(d.n0 + n) : d.roff + d.n0 + n) * d.ldt + d.k0 + 8 * c) = o; }
    LDS_WAIT(); asm volatile("" ::: "memory");
}
__device__ __forceinline__ void p0_fold_item(const float* wpool, const float* scale, const float* Wo, bf16* WT, LAS float* scr, int item, int lane) {
    const int g = item >> 8, nb = (item >> 2) & 63, ib = item & 3, dq = lane >> 4, n = nb * 16 + (lane & 15), i0 = ib * 32;
    const float* wo = Wo + (size_t)(512 + g * 128 + dq * 32) * 1024 + n; const float* sc = scale + g * 128 + dq * 32; const float* wp = wpool + ((size_t)g * 128 + i0) * 128;
    float w0[4], w1[4], w2[4];
#pragma unroll
    for (int e = 0; e < 4; ++e) { w0[e] = wo[(size_t)e * 1024] * sc[e]; w1[e] = wo[(size_t)(4 + e) * 1024] * sc[4 + e]; w2[e] = wo[(size_t)(8 + e) * 1024] * sc[8 + e]; }
#pragma unroll
    for (int j = 0; j < 16; ++j) *(LAS f32x4*)(scr + 4 * (lane + 64 * j)) = *(const GAS f32x4*)(wp + 4 * (lane + 64 * j));
    LDS_WAIT(); asm volatile("" ::: "memory");
    float a[32];
#pragma unroll
    for (int i = 0; i < 32; ++i) a[i] = 0.f;
#pragma unroll 1
    for (int d4 = 0; d4 < 8; ++d4) { float w3[4]; const int dn = d4 + 3 < 8 ? d4 + 3 : 7;
#pragma unroll
        for (int e = 0; e < 4; ++e) w3[e] = wo[(size_t)(4 * dn + e) * 1024] * sc[4 * dn + e];
#pragma unroll
        for (int i = 0; i < 32; ++i) { const f32x4 p = *(const LAS f32x4*)(scr + i * 128 + dq * 32 + 4 * d4); a[i] += (p[0] * w0[0] + p[1] * w0[1]) + (p[2] * w0[2] + p[3] * w0[3]); }
#pragma unroll
        for (int e = 0; e < 4; ++e) { w0[e] = w1[e]; w1[e] = w2[e]; w2[e] = w3[e]; } }
#pragma unroll
    for (int i = 0; i < 32; ++i) { a[i] += __shfl_xor(a[i], 16); a[i] += __shfl_xor(a[i], 32); }
    if (dq == 0) {
#pragma unroll
        for (int q = 0; q < 4; ++q) { float t[8];
#pragma unroll
            for (int e = 0; e < 8; ++e) t[e] = a[8 * q + e];
            *(GAS v4u*)(WT + (size_t)n * 1024 + 512 + g * 128 + i0 + 8 * q) = pack8(t); } }
    LDS_WAIT(); asm volatile("" ::: "memory");
}
__device__ __forceinline__ void p0_prologue(Frame& F) {
    LAS float* scr = (LAS float*)(F.lds + RING_OFF + F.wave * 16384);
    const int gw = F.vcu * NWAVES + F.wave, NGW = F.G * NWAVES;
    bf16* Win0 = (bf16*)(F.ws + WS_WIN0); bf16* Wout0 = (bf16*)(F.ws + WS_WOUT0); bf16* Win1 = (bf16*)(F.ws + WS_WIN1); bf16* Wout1 = (bf16*)(F.ws + WS_WOUT1);
    bf16* Wgu0 = (bf16*)(F.ws + WS_WGU0); bf16* Wgu1 = (bf16*)(F.ws + WS_WGU1); bf16* Wd0 = (bf16*)(F.ws + WS_WD0); bf16* Wd1 = (bf16*)(F.ws + WS_WD1);
    constexpr int I_IN = 16 * 64, I_OA = 8 * 32, I_O1 = 16 * 32, I_GU = 16 * 88, I_D = 44 * 32, I_F = 1024;
    constexpr int NITEMS = 2 * I_IN + I_OA + I_O1 + 4 * I_GU + 2 * I_D + I_F;
    for (int it = gw - NGW / 2; it >= 0 && it < I_F; it += NGW) p0_fold_item(F.in[6], F.in[7], F.in[8], Wout0, scr, it, F.lane);
    const auto decode = [&](int r) { P0Desc d; d.roff = 0; d.mm = 0; d.gain = nullptr;
        if (r < I_IN) { d.W = F.in[4]; d.ldw = 2048; d.WT = Win0; d.ldt = 1024; d.gain = F.in[1]; d.mm = 1; d.k0 = 64 * (r / 64); d.n0 = 32 * (r % 64); return d; } r -= I_IN;
        if (r < I_IN) { d.W = F.in[9]; d.ldw = 2048; d.WT = Win1; d.ldt = 1024; d.gain = F.in[1] + 1024; d.k0 = 64 * (r / 64); d.n0 = 32 * (r % 64); return d; } r -= I_IN;
        if (r < I_OA) { d.W = F.in[8]; d.ldw = 1024; d.WT = Wout0; d.ldt = 1024; d.k0 = 64 * (r / 32); d.n0 = 32 * (r % 32); return d; } r -= I_OA;
        if (r < I_O1) { d.W = F.in[13]; d.ldw = 1024; d.WT = Wout1; d.ldt = 1024; d.k0 = 64 * (r / 32); d.n0 = 32 * (r % 32); return d; } r -= I_O1;
        if (r < 4 * I_GU) { const int w = r / I_GU, rr = r % I_GU, l = w >> 1, isup = w & 1;
            d.W = (isup ? F.in[15] : F.in[14]) + (size_t)l * 1024 * DFF; d.ldw = DFF; d.WT = l ? Wgu1 : Wgu0; d.ldt = 1024; d.gain = F.in[2] + l * 1024;
            d.roff = ((32 * (rr % 88)) / 128) * 256 + ((32 * (rr % 88)) % 128) + isup * 128 - 32 * (rr % 88); d.k0 = 64 * (rr / 88); d.n0 = 32 * (rr % 88); return d; } r -= 4 * I_GU;
        { const int l = r / I_D, rr = r % I_D; d.W = F.in[18] + (size_t)l * DFF * 1024; d.ldw = 1024; d.WT = l ? Wd1 : Wd0; d.ldt = DFF; d.k0 = 64 * (rr / 32); d.n0 = 32 * (rr % 32); return d; } };
    constexpr int NT = NITEMS - I_F;
    { int it = gw; f32x4 v[8], vn[8]; float gn[8], gnn[8]; P0Desc cur, nxt;
      if (it < NT) { cur = decode(it); p0_titem_load(cur, F.lane, v, gn); }
      while (it < NT) { const int itn = it + NGW; const bool more = itn < NT;
          if (more) { nxt = decode(itn); p0_titem_load(nxt, F.lane, vn, gnn); }
          p0_titem_store(cur, scr, F.lane, v, gn);
          if (more) { cur = nxt;
#pragma unroll
              for (int i = 0; i < 8; ++i) { v[i] = vn[i]; gn[i] = gnn[i]; } }
          it = itn; } }
    bf16* hb = (bf16*)(F.ws + WS_HB); float* part0 = (float*)(F.ws + WS_PART);
    { f32x4 v[4][4], vn[4][4]; const bool lowh = gw < NGW / 2; const int qstep = NGW / 2, qend = lowh ? (M / 4) * 4 / 8 : M / 4; int m0 = (lowh ? gw : (M / 4) * 4 / 8 + gw - NGW / 2) * 4;
      const auto ldrows = [&](int mm, f32x4 (&d)[4][4]) {
#pragma unroll
          for (int q = 0; q < 4; ++q) { const GAS f32x4* xr = (const GAS f32x4*)(F.in[0] + (size_t)(mm + q) * D) + F.lane;
#pragma unroll
              for (int j = 0; j < 4; ++j) d[q][j] = __builtin_nontemporal_load((const f32x4*)xr + 64 * j); } };
      if (m0 < qend * 4) ldrows(m0, v);
      while (m0 < qend * 4) { const int m1 = m0 + qstep * 4; const bool more = m1 < qend * 4; float sq[4];
          if (more) ldrows(m1, vn);
#pragma unroll
          for (int q = 0; q < 4; ++q) { float t = 0.f;
#pragma unroll
              for (int j = 0; j < 4; ++j) t += (v[q][j].x * v[q][j].x + v[q][j].y * v[q][j].y) + (v[q][j].z * v[q][j].z + v[q][j].w * v[q][j].w);
              sq[q] = wave_sum(t);
              GAS unsigned long long* o8 = (GAS unsigned long long*)(hb + (size_t)(m0 + q) * D) + F.lane;
#pragma unroll
              for (int j = 0; j < 4; ++j) o8[64 * j] = (unsigned long long)pk2(v[q][j].x, v[q][j].y) | ((unsigned long long)pk2(v[q][j].z, v[q][j].w) << 32); }
          if (F.lane < 16) part0[(size_t)m0 * 4 + F.lane] = (F.lane & 3) ? 0.f : (F.lane == 0 ? sq[0] : F.lane == 4 ? sq[1] : F.lane == 8 ? sq[2] : sq[3]);
          if (more) {
#pragma unroll
              for (int q = 0; q < 4; ++q)
#pragma unroll
                  for (int j = 0; j < 4; ++j) v[q][j] = vn[q][j]; }
          m0 = m1; } }
}

template <class Sched> __device__ __forceinline__ void mix_fixup_local(Frame& F, const Sched& S) {
    pg8::Unit ua, ub; S.next(0, ua); S.next(1, ub);
    bf16* mix = (bf16*)(F.ws + WS_MIX);
    const int pm = ((F.tid >> 7) & 1) ? ub.pm : ua.pm, t = F.tid & 127; const bool seq_start = (pm % (SEQ / 256)) == 0;
    if (F.tid < 256) {
        const float* SZ = (const float*)(F.ws + WS_SZ); const int ch = 4 * t, w = 2 << (t >> 5);
        f32x4 zz[30];
#pragma unroll
        for (int i = 0; i < 15; ++i) zz[i] = (f32x4){0.f, 0.f, 0.f, 0.f};
        if (!seq_start) {
#pragma unroll
            for (int i = 0; i < 15; ++i) zz[i] = *(const GAS f32x4*)(SZ + ((size_t)(pm - 1) * 30 + 15 + i) * 512 + ch); }
#pragma unroll
        for (int i = 0; i < 15; ++i) zz[15 + i] = *(const GAS f32x4*)(SZ + ((size_t)pm * 30 + i) * 512 + ch);
#pragma unroll
        for (int j = 0; j < 15; ++j) { f32x4 sx = {0.f, 0.f, 0.f, 0.f};
#pragma unroll
            for (int k = 0; k < 16; ++k) { const f32x4 a = zz[15 + j - k]; if (k < w) sx += a; }
            const float rc = 1.0f / (float)(seq_start ? min(j + 1, w) : w); const f32x4 y = sx * rc - zz[15 + j];
            *(GAS unsigned long long*)(mix + (size_t)(pm * 256 + j) * D + 512 + ch) = (unsigned long long)pk2(y[0], y[1]) | ((unsigned long long)pk2(y[2], y[3]) << 32); }
    } else {
        const float* SAB = (const float*)(F.ws + WS_SAB); const float* SCV = (const float*)(F.ws + WS_SCV); const float* ca = F.in[5];
        const int oc = t & 63, j = t >> 6, ch = 8 * oc;
        const float* own = SCV + ((size_t)pm * 4) * 512 + ch; const float* prv = SCV + ((size_t)(pm - 1) * 4) * 512 + ch; float y[8];
#pragma unroll
        for (int e = 0; e < 8; ++e) { float p2 = 0.f, p1 = 0.f, c0;
            if (j == 0) { if (!seq_start) { p2 = prv[2 * 512 + e]; p1 = prv[3 * 512 + e]; } c0 = own[e]; }
            else { if (!seq_start) p2 = prv[3 * 512 + e]; p1 = own[e]; c0 = own[512 + e]; }
            y[e] = SAB[((size_t)pm * 2 + j) * 512 + ch + e] * (ca[ch + e] * p2 + ca[512 + ch + e] * p1 + ca[1024 + ch + e] * c0); }
        *(GAS v4u*)(mix + (size_t)(pm * 256 + j) * D + ch) = pack8(y);
    }
    VM_WAIT(); __syncthreads();
}

template <class Sched> __device__ __forceinline__ void fixup_local(Frame& F, const Sched& S, int layer) {
    const float* SG = (const float*)(F.ws + WS_SG); const float* SU = (const float*)(F.ws + WS_SU); bf16* act = (bf16*)(F.ws + WS_ACT);
    const float* cw = F.in[16] + (size_t)layer * 3 * DFF; const float* cb = F.in[17] + (size_t)layer * DFF;
    constexpr int NOCT = DFF / 8; int done = 0;
    for (int i = 0; ; ++i) { pg8::Unit un; if (!S.next(i, un)) break; const int slot = (un.pm >> 3) & 1; if (done & (1 << slot)) continue; done |= 1 << slot;
        const int pm = un.pm; const bool seq_start = (pm % (SEQ / 256)) == 0;
        for (int it = F.tid; it < 2 * NOCT; it += NWAVES * 64) {
            const int o = it % NOCT, j = it / NOCT, ch = 8 * o;
            float p2[8], p1[8], g[8], u[8], y[8];
#pragma unroll
            for (int e = 0; e < 8; ++e) { p2[e] = 0.f; p1[e] = 0.f; }
            const float* own = SG + ((size_t)pm * 4) * DFF + ch; const float* prv = SG + ((size_t)(pm - 1) * 4) * DFF + ch;
            if (j == 0) { if (!seq_start) {
#pragma unroll
                    for (int e = 0; e < 8; ++e) { p2[e] = prv[2 * DFF + e]; p1[e] = prv[3 * DFF + e]; } }
#pragma unroll
                for (int e = 0; e < 8; ++e) g[e] = own[e]; }
            else { if (!seq_start) {
#pragma unroll
                    for (int e = 0; e < 8; ++e) p2[e] = prv[3 * DFF + e]; }
#pragma unroll
                for (int e = 0; e < 8; ++e) { p1[e] = own[e]; g[e] = own[DFF + e]; } }
#pragma unroll
            for (int e = 0; e < 8; ++e) { u[e] = SU[((size_t)pm * 2 + j) * DFF + ch + e];
                y[e] = pg8::silu_f(cw[ch + e] * p2[e] + cw[DFF + ch + e] * p1[e] + cw[2 * DFF + ch + e] * g[e] + cb[ch + e]) * u[e]; }
            *(GAS v4u*)(act + (size_t)(pm * 256 + j) * DFF + ch) = pack8(y);
        } }
    VM_WAIT(); __syncthreads();
}

constexpr int VT_PITCH = 136;
__device__ __forceinline__ void sgu_phase(Frame& F) {
    const bf16* proj = (const bf16*)(F.ws + WS_PROJ); bf16* mix = (bf16*)(F.ws + WS_MIX); const float* vpart = (const float*)(F.ws + WS_PART + 3 * PART_BYTES);
    LAS bf16* vT = (LAS bf16*)(F.lds + RING_OFF); LAS float* rvs = (LAS float*)(F.lds + RING_OFF + 128 * VT_PITCH * 2);
    const int h = F.rk & 7, fr = F.lane & 15, fq = F.lane >> 4, wv = F.wave, t = 16 * wv + fr, qstep = F.G >> 6, nq = (F.xg + 1) * (SEQ / 128);
    float wsr[4][8];
#pragma unroll
    for (int ks = 0; ks < 4; ++ks) { const float* wp = F.in[11] + ((size_t)h * 128 + t) * 128 + 32 * ks + 8 * fq; const f32x4 a = *(const f32x4*)wp, b = *(const f32x4*)(wp + 4); const int s0 = 32 * ks + 8 * fq;
#pragma unroll
        for (int e = 0; e < 4; ++e) { wsr[ks][e] = (s0 + e > t) ? 0.f : a[e]; wsr[ks][4 + e] = (s0 + 4 + e > t) ? 0.f : b[e]; } }
    const float bias = F.in[12][h * 128 + t];
    f32x4 sg0[4], sg1[4];
#pragma unroll
    for (int p = 0; p < 4; ++p) { const int ch = h * 128 + 32 * p + 8 * fq; sg0[p] = *(const f32x4*)(F.in[10] + ch); sg1[p] = *(const f32x4*)(F.in[10] + ch + 4); }
    v4u vreg[4], ucur[4], unext[4]; f32x4 rvp = {0.f, 0.f, 0.f, 0.f};
    int q = F.xg * (SEQ / 128) + (F.rk >> 3);
    if (q < nq) { const int m0 = q * 128;
#pragma unroll
        for (int p = 0; p < 4; ++p) { const int pc = F.tid + 512 * p; vreg[p] = *(const GAS v4u*)(proj + (size_t)(m0 + (pc >> 4)) * EVEN_IN + 1024 + h * 128 + (pc & 15) * 8);
            unext[p] = *(const GAS v4u*)(proj + (size_t)(m0 + t) * EVEN_IN + h * 128 + 32 * p + 8 * fq); }
        if (F.tid < 128) rvp = *(const GAS f32x4*)(vpart + (size_t)(m0 + F.tid) * 4); }
    for (; q < nq; q += qstep) { const int m0 = q * 128;
        if (F.tid < 128) rvs[F.tid] = pg8::rinv_of(rvp);
#pragma unroll
        for (int p = 0; p < 4; ++p) { const int pc = F.tid + 512 * p, s = pc >> 4, c8 = (pc & 15) * 8; const v4u w = vreg[p]; const unsigned ww[4] = {w.x, w.y, w.z, w.w};
            const int sw = (((s >> 3) ^ (pc & 15)) << 3) | (s & 7);
#pragma unroll
            for (int e = 0; e < 4; ++e) { vT[(c8 + 2 * e) * VT_PITCH + sw] = (bf16)(ww[e] & 0xffffu); vT[(c8 + 2 * e + 1) * VT_PITCH + sw] = (bf16)(ww[e] >> 16); }
            ucur[p] = unext[p]; }
        LDS_WAIT(); __syncthreads();
        const int qn = q + qstep;
        if (qn < nq) { const int m1 = qn * 128;
#pragma unroll
            for (int p = 0; p < 4; ++p) { const int pc = F.tid + 512 * p; vreg[p] = *(const GAS v4u*)(proj + (size_t)(m1 + (pc >> 4)) * EVEN_IN + 1024 + h * 128 + (pc & 15) * 8);
                unext[p] = *(const GAS v4u*)(proj + (size_t)(m1 + t) * EVEN_IN + h * 128 + 32 * p + 8 * fq); }
            if (F.tid < 128) rvp = *(const GAS f32x4*)(vpart + (size_t)(m1 + F.tid) * 4); }
        pg8::bf16x8 wsf[4];
#pragma unroll
        for (int ks = 0; ks < 4; ++ks) { const f32x4 r0 = *(const LAS f32x4*)(rvs + 32 * ks + 8 * fq), r1 = *(const LAS f32x4*)(rvs + 32 * ks + 8 * fq + 4); float f[8];
#pragma unroll
            for (int e = 0; e < 4; ++e) { f[e] = wsr[ks][e] * r0[e]; f[4 + e] = wsr[ks][4 + e] * r1[e]; }
            const v4u w = pack8(f); wsf[ks] = __builtin_bit_cast(pg8::bf16x8, w); }
#pragma unroll
        for (int p = 0; p < 4; ++p) { pg8::f32x4 a0 = {0.f, 0.f, 0.f, 0.f}, a1 = {0.f, 0.f, 0.f, 0.f};
            const int cr = 32 * p + 8 * (fr >> 2) + (fr & 3);
#pragma unroll
            for (int ks = 0; ks < 4; ++ks) { const int ck = ((4 * ks + fq) ^ ((cr >> 3) & 15)) << 3;
                const pg8::bf16x8 v0 = *(const LAS pg8::bf16x8*)(vT + cr * VT_PITCH + ck), v1 = *(const LAS pg8::bf16x8*)(vT + (cr + 4) * VT_PITCH + ck);
                a0 = __builtin_amdgcn_mfma_f32_16x16x32_bf16(v0, wsf[ks], a0, 0, 0, 0); a1 = __builtin_amdgcn_mfma_f32_16x16x32_bf16(v1, wsf[ks], a1, 0, 0, 0); }
            float u[8], y[8]; unpack8(ucur[p], u);
#pragma unroll
            for (int e = 0; e < 4; ++e) { y[e] = u[e] * (sg0[p][e] * a0[e] + bias); y[4 + e] = u[4 + e] * (sg1[p][e] * a1[e] + bias); }
            *(GAS v4u*)(mix + (size_t)(m0 + t) * D + h * 128 + 32 * p + 8 * fq) = pack8(y); }
        __syncthreads();
    }
}

template <class Sched> __device__ __forceinline__ void fill_rtab(Frame& F, const Sched& S, const float* part) {
    LAS float* rtab = (LAS float*)(F.lds + RTAB_OFF); int done = 0;
    for (int i = 0; ; ++i) { pg8::Unit u; if (!S.next(i, u)) break; const int slot = (u.pm >> 3) & 1;
        if (!(done & (1 << slot))) { done |= 1 << slot; if (F.tid < 256) rtab[slot * 256 + F.tid] = pg8::rinv_from_part(part, u.pm * 256 + F.tid); } }
    LDS_WAIT(); __syncthreads();
}

struct Args { const float* in[19]; float* out; unsigned char* ws; int ph_lo, ph_hi, li, pad; };
__global__ void __launch_bounds__(NWAVES * 64, 2) trunk_fwd(Args args) {
    extern __shared__ __attribute__((aligned(16))) unsigned char lds[];
    Frame F;
    F.lds = (LAS unsigned char*)lds; F.MISC = (volatile LAS unsigned*)(F.lds + MISC_OFF);
    F.tid = threadIdx.x; F.lane = F.tid & 63; F.wave = __builtin_amdgcn_readfirstlane(F.tid >> 6);
    F.G = gridDim.x; { const int bx = blockIdx.x; F.xg = bx % 8; F.rk = bx / 8; F.vcu = F.xg * (F.G / 8) + F.rk; }
#pragma unroll
    for (int i = 0; i < 19; ++i) F.in[i] = args.in[i];
    F.out = args.out; F.ws = args.ws; F.ctl = (gu32*)(args.ws + WS_CTL);
    for (int u = F.tid; u < (LDS_BYTES - LDSCTL_OFF) / 4; u += NWAVES * 64) ((LAS unsigned*)(F.lds + LDSCTL_OFF))[u] = 0u;
    __syncthreads();
    XcdBarrier bar; bar.bar = (unsigned*)(F.ctl + CW_BAR); bar.x = 0; bar.st = nullptr;
    if (!MK_PER_PHASE) { bar.x = xb_xcc_id(); bar.st = F.MISC + 8;
        if (F.tid == 0) F.MISC[10] = xb_add(&bar.bar[XB_XCNT(bar.x)], 1u); }
    bool loc = false; unsigned* const locw = (unsigned*)(F.ctl + CW_LOC);
    const int lo = args.ph_lo, hi = args.ph_hi;
#define IN(k) (lo <= (k) && (k) < hi)
#define REP2(k, body) do { body; if ((DBL_MASK >> (k)) & 1) { xcd_barrier(bar); body; } } while (0)
#if PROBE_STAMP
#define STAMP_A(k) do { if (F.tid == 0) { F.MISC[15] = 0u; const unsigned t_ = (unsigned)__builtin_amdgcn_s_memrealtime(); if (PROBE_STAMP == (k) + 1 || PROBE_STAMP == 98 || PROBE_STAMP == 300 + (k)) F.MISC[13] += t_ - F.MISC[12]; F.MISC[12] = t_; } } while (0)
#define STAMP_L(k) do { if (F.tid == 0) { const unsigned t_ = (unsigned)__builtin_amdgcn_s_memrealtime(); if (PROBE_STAMP == 100 + (k) || PROBE_STAMP == 99) F.MISC[13] += t_ - F.MISC[12]; F.MISC[12] = t_; } } while (0)
#else
#define STAMP_A(k) do {} while (0)
#define STAMP_L(k) do {} while (0)
#endif
#define SEAM(k) do { if (IN(k) && IN((k) + 1)) { STAMP_A(k); if (loc) xcd_local_barrier(bar, locw); else xcd_barrier(bar); STAMP_L(k); } } while (0)
    unsigned char* ws = args.ws;
    bf16* HB = (bf16*)(ws + WS_HB); bf16* PROJ = (bf16*)(ws + WS_PROJ); bf16* MIX = (bf16*)(ws + WS_MIX); bf16* ACTB = (bf16*)(ws + WS_ACT);
    float* PART = (float*)(ws + WS_PART);
    using pg8::Gemm; using pg8::StaticOrder;
    typedef pg8::EpiProj<0, false> EP0; typedef pg8::EpiProj<1, true> EP1; typedef pg8::EpiResid<false> ER1;
    int c = (int)blockIdx.x; LAS float* RED = (LAS float*)(F.lds + RED_OFF); const LAS float* RTAB = (const LAS float*)(F.lds + RTAB_OFF);

#if PROBE_STAMP
    if (F.tid == 0) { F.MISC[12] = (unsigned)__builtin_amdgcn_s_memrealtime(); F.MISC[13] = 0u; }
#endif
    if (IN(0)) { REP2(0, p0_prologue(F)); } SEAM(0);
    if (!MK_PER_PHASE && IN(0) && IN(1)) {
        if (F.tid == 0) { unsigned ok = (F.G % 8 == 0) ? 1u : 0u;
            for (unsigned j = 0; j < 16; ++j) { const unsigned cj = xb_ld(&bar.bar[XB_XCNT(j)]); ok &= (cj == (j < 8u ? (unsigned)F.G / 8u : 0u)) ? 1u : 0u; }
            F.MISC[11] = LOCAL_BARRIERS ? ok : 0u; }
        __syncthreads();
        loc = F.MISC[11] != 0u;
        if (loc) { F.xg = (int)bar.x; F.rk = (int)F.MISC[10]; F.vcu = F.xg * (F.G / 8) + F.rk; c = F.rk * 8 + F.xg; }
    }
    if (IN(1)) { PHASE_BEGIN(1);
        Gemm g{HB, (const bf16*)(ws + WS_WIN0), M, EVEN_IN, D}; StaticOrder S; S.init(M, EVEN_IN, F.G, c, 1 + PROBE_REP * ((DBL_MASK >> 1) & 1), NOEPI_MODE * ((NOEPI_MASK >> 1) & 1));
        { LAS float* cal = (LAS float*)(F.lds + CAL_OFF); for (int i = F.tid; i < 3 * 512; i += NWAVES * 64) cal[i] = F.in[5][i]; }
        fill_rtab(F, S, PART);
        pg8::EpiMix E{MIX, (float*)(ws + WS_SZ), RTAB, (const LAS float*)(F.lds + CAL_OFF), (float*)(ws + WS_SAB), (float*)(ws + WS_SCV), (LAS float*)(F.lds + XCH_OFF)};
        pg8::gemm_phase<pg8::EpiMix, StaticOrder, true, true>(F.lds + RING_OFF, g, S, E); } SEAM(1);
    if (IN(3)) { PHASE_BEGIN(3);
        Gemm g{MIX, (const bf16*)(ws + WS_WOUT0), M, D, D}; StaticOrder S; S.init(M, D, F.G, c, 1 + PROBE_REP * ((DBL_MASK >> 3) & 1), NOEPI_MODE * ((NOEPI_MASK >> 3) & 1)); mix_fixup_local(F, S);
        ER1 E{HB, nullptr, PART + 1 * (size_t)M * 16, RED};
        pg8::gemm_phase<ER1, StaticOrder, true, true>(F.lds + RING_OFF, g, S, E); } SEAM(3);
    if (IN(4)) { PHASE_BEGIN(4);
        Gemm g{HB, (const bf16*)(ws + WS_WGU0), M, NGU, D}; StaticOrder S; S.init(M, NGU, F.G, c, 1 + PROBE_REP * ((DBL_MASK >> 4) & 1), NOEPI_MODE * ((NOEPI_MASK >> 4) & 1));
        fill_rtab(F, S, PART + 1 * (size_t)M * 16); pg8::EpiFfn E{ACTB, RTAB, F.in[16], F.in[17], (float*)(ws + WS_SG), (float*)(ws + WS_SU), (LAS float*)(F.lds + XCH_OFF), (LAS float*)(F.lds + CWL_OFF)};
        pg8::gemm_phase<pg8::EpiFfn, StaticOrder, true, true>(F.lds + RING_OFF, g, S, E); } SEAM(4);
    if (IN(6)) { PHASE_BEGIN(6);
        Gemm g{ACTB, (const bf16*)(ws + WS_WD0), M, D, DFF}; StaticOrder S; S.init(M, D, F.G, c, 1 + PROBE_REP * ((DBL_MASK >> 6) & 1), NOEPI_MODE * ((NOEPI_MASK >> 6) & 1)); fixup_local(F, S, 0);
        ER1 E{HB, nullptr, PART + 2 * (size_t)M * 16, RED};
        pg8::gemm_phase<ER1, StaticOrder, true, true>(F.lds + RING_OFF, g, S, E); } SEAM(6);
    if (IN(7)) { PHASE_BEGIN(7);
        Gemm g{HB, (const bf16*)(ws + WS_WIN1), M, EVEN_IN, D}; StaticOrder S; S.init(M, EVEN_IN, F.G, c, 1 + PROBE_REP * ((DBL_MASK >> 7) & 1), NOEPI_MODE * ((NOEPI_MASK >> 7) & 1));
        fill_rtab(F, S, PART + 2 * (size_t)M * 16); EP1 E{PROJ, EVEN_IN, RTAB, PART + 3 * (size_t)M * 16, 4, RED};
        pg8::gemm_phase<EP1, StaticOrder, true, true>(F.lds + RING_OFF, g, S, E); } SEAM(7);
    if (IN(8)) { REP2(8, sgu_phase(F)); } SEAM(8);
    if (IN(9)) { PHASE_BEGIN(9);
        Gemm g{MIX, (const bf16*)(ws + WS_WOUT1), M, D, D}; StaticOrder S; S.init(M, D, F.G, c, 1 + PROBE_REP * ((DBL_MASK >> 9) & 1), NOEPI_MODE * ((NOEPI_MASK >> 9) & 1));
        ER1 E{HB, nullptr, PART + 4 * (size_t)M * 16, RED};
        pg8::gemm_phase<ER1, StaticOrder, true, true>(F.lds + RING_OFF, g, S, E); } SEAM(9);
    if (IN(10)) { PHASE_BEGIN(10);
        Gemm g{HB, (const bf16*)(ws + WS_WGU1), M, NGU, D}; StaticOrder S; S.init(M, NGU, F.G, c, 1 + PROBE_REP * ((DBL_MASK >> 10) & 1), NOEPI_MODE * ((NOEPI_MASK >> 10) & 1));
        fill_rtab(F, S, PART + 4 * (size_t)M * 16); pg8::EpiFfn E{ACTB, RTAB, F.in[16] + 3 * DFF, F.in[17] + DFF, (float*)(ws + WS_SG), (float*)(ws + WS_SU), (LAS float*)(F.lds + XCH_OFF), (LAS float*)(F.lds + CWL_OFF)};
        pg8::gemm_phase<pg8::EpiFfn, StaticOrder, true, true>(F.lds + RING_OFF, g, S, E); } SEAM(10);
    if (IN(12)) { PHASE_BEGIN(12);
        Gemm g{ACTB, (const bf16*)(ws + WS_WD1), M, D, DFF}; StaticOrder S; S.init(M, D, F.G, c, 1, 0); fixup_local(F, S, 1);
        pg8::EpiFinal E{HB, F.out, PART, (unsigned*)(F.ctl + CW_CNT), F.in[3], RED};
        pg8::gemm_phase<pg8::EpiFinal, StaticOrder, true, true>(F.lds + RING_OFF, g, S, E); }
#if PROBE_STAMP
    STAMP_A(12);
    if (F.tid == 0 && (PROBE_FILTER == 0 || (PROBE_FILTER <= 2 && (PROBE_FILTER == 1) == ((blockIdx.x & 7) < 4)) || (PROBE_FILTER >= 3 && (PROBE_FILTER == 3) == (F.rk < 4)))) xb_add((unsigned*)(F.ctl + 2048), PROBE_STAMP >= 300 ? F.MISC[13] - F.MISC[14] : PROBE_STAMP >= 200 ? F.MISC[14] : F.MISC[13]);
    xcd_barrier(bar);
    if (blockIdx.x == 0 && F.tid == 0) F.out[0] = ((float)xb_ld((unsigned*)(F.ctl + 2048)) * (1.0f / (100.0f * 256.0f)) - PROBE_OFF) * PROBE_SCALE;
#endif
#undef IN
#undef SEAM
#undef REP2
}

extern "C" void kernel_launch(void* const* d_in, const int* in_sizes, int n_in, void* d_out, int out_size, void* d_ws, size_t ws_size, hipStream_t stream) {
    static int grid = 0;
    if (grid == 0) {
        if (n_in != 19 || in_sizes[0] != M * D || out_size != M * D || ws_size < WS_END) { fprintf(stderr, "kernel_launch: unexpected shapes: n_in %d in0 %d out %d ws %zu (need %zu)\n", n_in, n_in > 0 ? in_sizes[0] : -1, out_size, ws_size, (size_t)WS_END); grid = -1; return; }
        int dev = 0, cus = 0, per_cu = 0;
        if (hipGetDevice(&dev) != hipSuccess || hipDeviceGetAttribute(&cus, hipDeviceAttributeMultiprocessorCount, dev) != hipSuccess) { fprintf(stderr, "kernel_launch: device query failed\n"); grid = -1; return; }
        if (hipFuncSetAttribute((const void*)trunk_fwd, hipFuncAttributeMaxDynamicSharedMemorySize, LDS_BYTES) != hipSuccess) { fprintf(stderr, "kernel_launch: hipFuncSetAttribute failed\n"); grid = -1; return; }
        if (hipOccupancyMaxActiveBlocksPerMultiprocessor(&per_cu, (const void*)trunk_fwd, NWAVES * 64, LDS_BYTES) != hipSuccess || per_cu < 1) { fprintf(stderr, "kernel_launch: occupancy query says %d blocks per CU\n", per_cu); }
        (void)hipGetLastError();
        grid = cus;
        if (grid != 256) { fprintf(stderr, "kernel_launch: built for a 256-CU device (static unit order, row-panel pairing); found %d CUs; nothing launched\n", grid); grid = -1; return; }
    }
    if (grid < 0) return;
    (void)hipMemsetAsync((char*)d_ws + WS_CTL, 0, CTL_ZERO_BYTES, stream);
    Args a{};
    for (int i = 0; i < 19; ++i) a.in[i] = (const float*)d_in[i];
    a.out = (float*)d_out; a.ws = (unsigned char*)d_ws;
#if MK_PER_PHASE
    for (int li = 0; li < NPHASE; ++li) { a.ph_lo = li; a.ph_hi = li + 1; a.li = li; hipLaunchKernelGGL(trunk_fwd, dim3(grid), dim3(NWAVES * 64), LDS_BYTES, stream, a); }
#else
    a.ph_lo = 0; a.ph_hi = NPHASE; a.li = 0;
    hipLaunchKernelGGL(trunk_fwd, dim3(grid), dim3(NWAVES * 64), LDS_BYTES, stream, a);
#endif
    const hipError_t le = hipPeekAtLastError();
    if (le != hipSuccess) fprintf(stderr, "kernel_launch: launch failed: %s\n", hipGetErrorName(le));
}
```
